# Optimizing an MI355X kernel written in HIP

```python
import math
import jax, jax.numpy as jnp
from jax import lax
import numpy as np

D_MODEL = 1024
BATCH = 4
SEQ = 4096
DEPTH = 4

HEAD_DIM = 64
ROPE_DIM = 16
ROPE_THETA = 500000.0
GRID_W = 64
NA_HEADS = 8
NA_WIN_R = 8
NA_WIN_C = 16
NA_QCOL_BLOCK = 16
NA_KCOL_SPAN = 32
DIFF_HEADS = 4
DIFF_V_DIM = 128
DIFF_Q_BLOCK = 128
DIL_PATTERNS = ((128, 1), (512, 4), (2048, 16))
DIL_HEADS_PER_GROUP = 4
DIL_HEADS = 12
DIL_Q_BLOCK = 64
A_W = 512
B_QK_W = 512
B_V_W = 512
C_W = 768
C_OUT_W = 256
N_BRANCH = 3
IN_W = 3 * A_W + 2 * B_QK_W + B_V_W + 3 * C_W + N_BRANCH * D_MODEL
N_GROUPS = 4
EXPERTS_PER_GROUP = 4
N_EXPERTS = 16
TOP_K = 2
D_FF_EXPERT = D_MODEL // 2
NORM_EPS = 1e-6
SUBLN_EPS = 1e-5
NEG_INF = -1e30

kernel_name = 'hybrid_na_diff_dilated_hmoe_encoder'


def rmsnorm(x, g, eps=NORM_EPS):
    xf = x.astype(jnp.float32)
    y = xf * lax.rsqrt(jnp.mean(xf * xf, axis=-1, keepdims=True) + eps)
    return (y * g.astype(jnp.float32)).astype(x.dtype)


def rope_tables(T):
    inv = 1.0 / (ROPE_THETA ** (jnp.arange(0, ROPE_DIM, 2, dtype=jnp.float32) / ROPE_DIM))
    ang = jnp.arange(T, dtype=jnp.float32)[:, None] * inv[None, :]
    return jnp.cos(ang), jnp.sin(ang)


def partial_rope(x, cos, sin):
    half = ROPE_DIM // 2
    xr = x[..., :ROPE_DIM].astype(jnp.float32)
    x1, x2 = xr[..., :half], xr[..., half:]
    c = cos[None, :, None, :]
    s = sin[None, :, None, :]
    rot = jnp.concatenate([x1 * c - x2 * s, x2 * c + x1 * s], axis=-1).astype(x.dtype)
    return jnp.concatenate([rot, x[..., ROPE_DIM:]], axis=-1)


def neighbourhood_attention(q, k, v, rpb):
    B, T, H, dh = q.shape
    rows = T // GRID_W
    wr = min(NA_WIN_R, rows)
    ncb = GRID_W // NA_QCOL_BLOCK

    def grid(t):
        return t.reshape(B, rows, GRID_W, H, dh).transpose(0, 3, 1, 2, 4)

    qg, kg, vg = grid(q), grid(k), grid(v)
    qc = np.arange(GRID_W).reshape(ncb, NA_QCOL_BLOCK)
    cs = np.clip(np.arange(ncb) * NA_QCOL_BLOCK - NA_WIN_C // 2, 0, GRID_W - NA_KCOL_SPAN)
    kc = cs[:, None] + np.arange(NA_KCOL_SPAN)[None, :]
    c0 = np.clip(qc - NA_WIN_C // 2, 0, GRID_W - NA_WIN_C)
    col_ok = (kc[:, None, :] >= c0[:, :, None]) & (kc[:, None, :] < c0[:, :, None] + NA_WIN_C)
    dc_idx = np.clip(kc[:, None, :] - qc[:, :, None] + NA_WIN_C - 1, 0, 2 * NA_WIN_C - 2)
    rpb_c = rpb[:, :, dc_idx]
    col_mask = jnp.asarray(col_ok)[None, None, :, :, None, :]
    kc_j = jnp.asarray(kc)
    scale = dh ** -0.5

    def one_row(r):
        r0 = jnp.clip(r - wr // 2, 0, rows - wr)
        q_r = lax.dynamic_index_in_dim(qg, r, axis=2, keepdims=False)
        k_b = lax.dynamic_slice_in_dim(kg, r0, wr, axis=2)[:, :, :, kc_j]
        v_b = lax.dynamic_slice_in_dim(vg, r0, wr, axis=2)[:, :, :, kc_j]
        q_r = q_r.reshape(B, H, ncb, NA_QCOL_BLOCK, dh)
        s = jnp.einsum('bhcqd,bhrckd->bhcqrk', q_r, k_b,
                       preferred_element_type=jnp.float32) * scale
        dr = r0 + jnp.arange(wr) - r + NA_WIN_R - 1
        bias = jnp.take(rpb_c, dr, axis=1).transpose(0, 2, 3, 1, 4)
        s = jnp.where(col_mask, s + bias.astype(jnp.float32)[None], NEG_INF)
        p = jax.nn.softmax(s.reshape(B, H, ncb, NA_QCOL_BLOCK, wr * NA_KCOL_SPAN), axis=-1)
        p = p.reshape(s.shape).astype(v.dtype)
        o = jnp.einsum('bhcqrk,bhrckd->bhcqd', p, v_b)
        return o.reshape(B, H, GRID_W, dh)

    out = lax.map(one_row, jnp.arange(rows))
    return out.transpose(1, 0, 3, 2, 4).reshape(B, T, H * dh)


def differential_attention(q, k, v, lam, lam_init, subln_g):
    B, T, H, _, dh = q.shape
    nb = T // DIFF_Q_BLOCK
    scale = dh ** -0.5
    qb = q.reshape(B, nb, DIFF_Q_BLOCK, H, 2, dh).transpose(1, 0, 3, 4, 2, 5)
    kt = k.transpose(0, 2, 3, 1, 4)
    vt = v.transpose(0, 2, 1, 3)

    def one_block(q_blk):
        s = jnp.einsum('bhcqd,bhckd->bhcqk', q_blk, kt,
                       preferred_element_type=jnp.float32) * scale
        p = jax.nn.softmax(s, axis=-1)
        a = p[:, :, 0] - lam * p[:, :, 1]
        return jnp.einsum('bhqk,bhkd->bhqd', a.astype(v.dtype), vt)

    o = lax.map(one_block, qb)
    o = o.transpose(1, 0, 3, 2, 4).reshape(B, T, H, 2 * dh)
    o = rmsnorm(o, subln_g, SUBLN_EPS) * (1.0 - lam_init)
    return o.reshape(B, T, H * 2 * dh)


def dilated_group(q, k, v, dil, radius):
    B, T, H, dh = q.shape
    L = T // dil
    nb = -(-L // DIL_Q_BLOCK)
    Lp = nb * DIL_Q_BLOCK
    kb = DIL_Q_BLOCK + 2 * radius

    def phase(t):
        return t.reshape(B, L, dil, H, dh).transpose(0, 2, 3, 1, 4)

    qp = jnp.pad(phase(q), ((0, 0), (0, 0), (0, 0), (0, Lp - L), (0, 0)))
    pad_k = ((0, 0), (0, 0), (0, 0), (radius, Lp - L + radius), (0, 0))
    kp = jnp.pad(phase(k), pad_k)
    vp = jnp.pad(phase(v), pad_k)
    idx = np.arange(nb)[:, None] * DIL_Q_BLOCK + np.arange(kb)[None, :]
    k_blk = kp[:, :, :, idx]
    v_blk = vp[:, :, :, idx]
    q_blk = qp.reshape(B, dil, H, nb, DIL_Q_BLOCK, dh)
    s = jnp.einsum('bphnqd,bphnkd->bphnqk', q_blk, k_blk,
                   preferred_element_type=jnp.float32) * (dh ** -0.5)
    key_pos = idx - radius
    q_pos = np.arange(Lp).reshape(nb, DIL_Q_BLOCK)
    rel = key_pos[:, None, :] - q_pos[:, :, None]
    ok = (np.abs(rel) <= radius) & (key_pos[:, None, :] >= 0) & (key_pos[:, None, :] < L)
    s = jnp.where(jnp.asarray(ok), s, NEG_INF)
    lse = jax.nn.logsumexp(s, axis=-1)
    p = jnp.exp(s - lse[..., None]).astype(v.dtype)
    o = jnp.einsum('bphnqk,bphnkd->bphnqd', p, v_blk)
    o = o.reshape(B, dil, H, Lp, dh)[:, :, :, :L].transpose(0, 3, 1, 2, 4).reshape(B, T, H, dh)
    lse = lse.reshape(B, dil, H, Lp)[:, :, :, :L].transpose(0, 3, 1, 2).reshape(B, T, H)
    return o, lse


def dilated_mixture(q, k, v):
    B, T = q.shape[0], q.shape[1]
    outs, lses = [], []
    for g, (window, dil) in enumerate(DIL_PATTERNS):
        sl = slice(g * DIL_HEADS_PER_GROUP, (g + 1) * DIL_HEADS_PER_GROUP)
        o, l = dilated_group(q[:, :, sl], k[:, :, sl], v[:, :, sl], dil, window // (2 * dil))
        outs.append(o)
        lses.append(l)
    o = jnp.stack(outs, axis=0)
    wts = jax.nn.softmax(jnp.stack(lses, axis=0), axis=0)
    y = jnp.sum(o * wts[..., None].astype(o.dtype), axis=0)
    return y.reshape(B, T, C_OUT_W)


def hybrid_mixer(xn, w_in, rpb, lq1, lk1, lq2, lk2, subln_g, w_pa, w_pb, w_pc, w_o, lam_init, cos, sin):
    B, T, _ = xn.shape
    proj = xn @ w_in
    widths = [A_W] * 3 + [B_QK_W] * 2 + [B_V_W] + [C_W] * 3 + [D_MODEL] * 2
    cuts = [int(c) for c in np.cumsum(widths)]
    qa, ka, va, qb, kb, vb, qc, kc, vc, ga, gb, gc = jnp.split(proj, cuts, axis=-1)

    def heads(t, h):
        return t.reshape(B, T, h, HEAD_DIM)

    ya = neighbourhood_attention(heads(qa, NA_HEADS), heads(ka, NA_HEADS), heads(va, NA_HEADS), rpb)
    qb = partial_rope(heads(qb, 2 * DIFF_HEADS), cos, sin).reshape(B, T, DIFF_HEADS, 2, HEAD_DIM)
    kb = partial_rope(heads(kb, 2 * DIFF_HEADS), cos, sin).reshape(B, T, DIFF_HEADS, 2, HEAD_DIM)
    vb = vb.reshape(B, T, DIFF_HEADS, DIFF_V_DIM)
    f32 = jnp.float32
    lam = (jnp.exp(jnp.sum(lq1.astype(f32) * lk1.astype(f32)))
           - jnp.exp(jnp.sum(lq2.astype(f32) * lk2.astype(f32))) + lam_init)
    yb = differential_attention(qb, kb, vb, lam, lam_init, subln_g)
    yc = dilated_mixture(partial_rope(heads(qc, DIL_HEADS), cos, sin),
                         partial_rope(heads(kc, DIL_HEADS), cos, sin),
                         heads(vc, DIL_HEADS))
    merged = (jax.nn.sigmoid(ga) * (ya @ w_pa) + jax.nn.sigmoid(gb) * (yb @ w_pb)
              + jax.nn.sigmoid(gc) * (yc @ w_pc))
    return merged @ w_o


def hierarchical_moe(xn, wg, bg, we, be, w1, w3, w2):
    B, T, D = xn.shape
    xf = xn.reshape(-1, D)
    N = xf.shape[0]
    g_logits = (xf @ wg).astype(jnp.float32) + bg.astype(jnp.float32)
    g_prob = jax.nn.softmax(g_logits, axis=-1)
    g_sel = jnp.argmax(g_logits, axis=-1)
    g_gate = jnp.take_along_axis(g_prob, g_sel[:, None], axis=-1)
    e_logits = ((xf @ we).astype(jnp.float32) + be.astype(jnp.float32)).reshape(N, N_GROUPS, EXPERTS_PER_GROUP)
    e_logits = jnp.take_along_axis(e_logits, g_sel[:, None, None], axis=1)[:, 0]
    top_v, top_i = lax.top_k(e_logits, TOP_K)
    top_w = jax.nn.softmax(top_v, axis=-1) * g_gate
    eid = g_sel[:, None] * EXPERTS_PER_GROUP + top_i
    combine = jnp.sum(jax.nn.one_hot(eid, N_EXPERTS, dtype=jnp.float32) * top_w[..., None], axis=1)
    combine = combine.astype(xf.dtype)
    out = jnp.zeros_like(xf)
    for e in range(N_EXPERTS):
        h = jax.nn.silu(xf @ w1[e]) * (xf @ w3[e])
        out = out + combine[:, e:e + 1] * (h @ w2[e])
    return out.reshape(B, T, D)


def setup_inputs(seed: int = 0) -> dict:
    key = jax.random.key(seed)
    ks = jax.random.split(key, 22)
    L = DEPTH

    def nrm(k, shape, scale):
        return jax.random.normal(k, shape, jnp.float32) * scale

    return {
        'x': nrm(ks[0], (BATCH, SEQ, D_MODEL), 1.0),
        'w_in': nrm(ks[1], (L, D_MODEL, IN_W), D_MODEL ** -0.5),
        'na_rpb': nrm(ks[2], (L, NA_HEADS, 2 * NA_WIN_R - 1, 2 * NA_WIN_C - 1), 0.02),
        'lam_q1': nrm(ks[3], (L, HEAD_DIM), 0.1),
        'lam_k1': nrm(ks[4], (L, HEAD_DIM), 0.1),
        'lam_q2': nrm(ks[5], (L, HEAD_DIM), 0.1),
        'lam_k2': nrm(ks[6], (L, HEAD_DIM), 0.1),
        'diff_subln': 1.0 + nrm(ks[7], (L, DIFF_V_DIM), 0.01),
        'w_pa': nrm(ks[8], (L, A_W, D_MODEL), A_W ** -0.5),
        'w_pb': nrm(ks[9], (L, B_V_W, D_MODEL), B_V_W ** -0.5),
        'w_pc': nrm(ks[10], (L, C_OUT_W, D_MODEL), C_OUT_W ** -0.5),
        'w_o': nrm(ks[11], (L, D_MODEL, D_MODEL), D_MODEL ** -0.5),
        'norm_mix': 1.0 + nrm(ks[12], (L, D_MODEL), 0.01),
        'norm_ffn': 1.0 + nrm(ks[13], (L, D_MODEL), 0.01),
        'router_group_w': nrm(ks[14], (L, D_MODEL, N_GROUPS), D_MODEL ** -0.5),
        'router_group_b': nrm(ks[15], (L, N_GROUPS), 0.01),
        'router_expert_w': nrm(ks[16], (L, D_MODEL, N_EXPERTS), D_MODEL ** -0.5),
        'router_expert_b': nrm(ks[17], (L, N_EXPERTS), 0.01),
        'w1': nrm(ks[18], (L, N_EXPERTS, D_MODEL, D_FF_EXPERT), D_MODEL ** -0.5),
        'w3': nrm(ks[19], (L, N_EXPERTS, D_MODEL, D_FF_EXPERT), D_MODEL ** -0.5),
        'w2': nrm(ks[20], (L, N_EXPERTS, D_FF_EXPERT, D_MODEL), D_FF_EXPERT ** -0.5),
        'norm_final': 1.0 + nrm(ks[21], (D_MODEL,), 0.01),
    }


def reference(x, w_in, na_rpb, lam_q1, lam_k1, lam_q2, lam_k2, diff_subln, w_pa, w_pb, w_pc, w_o,
              norm_mix, norm_ffn, router_group_w, router_group_b, router_expert_w, router_expert_b,
              w1, w3, w2, norm_final):
    T = x.shape[1]
    cos, sin = rope_tables(T)
    h = x
    for l in range(DEPTH):
        lam_init = 0.8 - 0.6 * math.exp(-0.3 * l)
        h = h + hybrid_mixer(rmsnorm(h, norm_mix[l]), w_in[l], na_rpb[l], lam_q1[l], lam_k1[l],
                             lam_q2[l], lam_k2[l], diff_subln[l], w_pa[l], w_pb[l], w_pc[l], w_o[l],
                             lam_init, cos, sin)
        h = h + hierarchical_moe(rmsnorm(h, norm_ffn[l]), router_group_w[l], router_group_b[l],
                                 router_expert_w[l], router_expert_b[l], w1[l], w3[l], w2[l])
    return rmsnorm(h, norm_final)
```

```cpp
#include <hip/hip_runtime.h>
#include <cstdio>
#include <cstdint>
#define MK_ONE_LAUNCH 1
namespace pg8 {
#define PG8_LAS __attribute__((address_space(3)))
typedef unsigned short bf16_t;
typedef short bf16x8 __attribute__((ext_vector_type(8)));
typedef float f32x4 __attribute__((ext_vector_type(4)));
typedef unsigned u32x4 __attribute__((ext_vector_type(4)));
constexpr int BM = 256, BK = 64, HALF = 128, HTB = HALF * BK * 2  , STAGE_BYTES = 8 * HTB, NXCD = 8, WGM = 8;

__host__ __device__ __forceinline__ int lds_byte(int r, int c) { const int st = (r >> 4) * 2 + (c >> 5), rr = r & 15, cc = c & 31, ob = rr * 64 + cc * 2; return st * 1024 + (ob ^ (((ob >> 9) & 1) << 5)); }
__host__ __device__ __forceinline__ void stage_rc(int b, int& R, int& C) { const int st = b / 1024, sb = b % 1024, swz = sb ^ (((sb >> 9) & 1) << 5); R = (st >> 1) * 16 + swz / 64; C = (st & 1) * 32 + (swz % 64) / 2; }
__host__ __device__ __forceinline__ int perm32(int rho) { const int n = rho >> 4, i = rho & 15; return 8 * (i >> 2) + 4 * n + (i & 3); }

struct Unit { int pm, pn, e, rt, cnt; };
struct Gemm { const bf16_t* A; const bf16_t* Bt; int M, N, K; };

struct StaticOrder {
    int nM, nN, nwg, G, c;
    __host__ __device__ void init(int M, int N, int G_, int c_) { nM = M / BM; nN = N / BM; nwg = nM * nN; G = G_; c = c_; }
    __host__ __device__ bool next(int i, Unit& u) const {
        const long L = (long)i * G + c; if (L >= nwg) return false;
        int wgid = (int)L; { const int q = nwg / NXCD, r = nwg % NXCD, xcd = wgid % NXCD, off = wgid / NXCD; wgid = (xcd < r ? xcd * (q + 1) : r * (q + 1) + (xcd - r) * q) + off; }
        const int nig = WGM * nN, gid = wgid / nig, fm = gid * WGM, gsz = (nM - fm) < WGM ? (nM - fm) : WGM;
        u.pm = fm + ((wgid % nig) % gsz); u.pn = (wgid % nig) / gsz; return true;
    }
    __device__ __forceinline__ void a_ready(const Unit&) const {}
    __device__ __forceinline__ void done(const Unit&) const {}
};
__device__ __forceinline__ unsigned cvt_pk_bf16(float lo, float hi) { unsigned r; asm volatile("v_cvt_pk_bf16_f32 %0, %1, %2" : "=v"(r) : "v"(lo), "v"(hi)); return r; }

__device__ __forceinline__ int opq_tid() { int t = threadIdx.x; asm volatile("" : "+v"(t)); return t; }
template <class Epi, class Sched, bool ALIGN_EPI = false, bool SP2 = false>
__device__ __forceinline__ void gemm_phase(PG8_LAS unsigned char* lds, const Gemm g, const Sched& S, const Epi& E) {
    const int tid = opq_tid(), wid = __builtin_amdgcn_readfirstlane(tid >> 6), lane = tid & 63, wr = wid >> 2, wc = wid & 3, fr = lane & 15, fq = lane >> 4;
    const int K = g.K, nt = K / BK;
    unsigned voffA[2], voffB[2];
#pragma unroll
    for (int i = 0; i < 2; ++i) { int R, C; stage_rc(tid * 16 + i * 8192, R, C); const int Rb = Epi::PERM ? ((R & ~31) + perm32(R & 31)) : R;
        voffA[i] = (unsigned)(R * K + C) * 2u; voffB[i] = (unsigned)(Rb * K + C) * 2u; }
    const size_t kstep = (size_t)(BK * 2);
    const size_t hstep = (size_t)HALF * K * 2;
    const size_t tstep = 2 * hstep;
    const unsigned ldsw = (unsigned)wid * 1024u;
    const int aoff = lds_byte(wr * 64 + fr, fq * 8), boff = lds_byte(wc * 32 + fr, fq * 8);
#define PG8_SA(b, h) (((b) * 2 + (h)) * HTB)
#define PG8_SB(b, h) ((4 + (b) * 2 + (h)) * HTB)
#define PG8_STAGE(bufoff, gbase, voff) do { _Pragma("unroll") for (int _i = 0; _i < 2; ++_i) \
        __builtin_amdgcn_global_load_lds((const unsigned*)((const char*)(gbase) + (voff)[_i]), (PG8_LAS unsigned*)(lds + (bufoff) + ldsw + _i * 8192), 16, 0, 0); } while (0)
#define PG8_LDA(dst, b, h) do { _Pragma("unroll") for (int m = 0; m < 4; ++m) _Pragma("unroll") for (int k = 0; k < 2; ++k) dst[m][k] = *(const PG8_LAS bf16x8*)(lds + PG8_SA(b, h) + aoff + m * 2048 + k * 1024); } while (0)
#define PG8_LDB(dst, b, h) do { _Pragma("unroll") for (int n = 0; n < 2; ++n) _Pragma("unroll") for (int k = 0; k < 2; ++k) dst[n][k] = *(const PG8_LAS bf16x8*)(lds + PG8_SB(b, h) + boff + n * 2048 + k * 1024); } while (0)
#define PG8_MMA(ai, bj, At, Bt) do { __builtin_amdgcn_s_setprio(1); _Pragma("unroll") for (int m = 0; m < 4; ++m) _Pragma("unroll") for (int n = 0; n < 2; ++n) _Pragma("unroll") for (int k = 0; k < 2; ++k) \
        acc[ai][bj][m][n] = __builtin_amdgcn_mfma_f32_16x16x32_bf16(Bt[n][k], At[m][k], acc[ai][bj][m][n], 0, 0, 0); __builtin_amdgcn_s_setprio(0); } while (0)
#define PG8_WAIT_V(n) asm volatile("s_waitcnt vmcnt(" #n ")" ::: "memory")
#define PG8_WAIT_L(n) asm volatile("s_waitcnt lgkmcnt(" #n ")" ::: "memory")
#define PG8_BAR __builtin_amdgcn_s_barrier()
#define PG8_SCHED __builtin_amdgcn_sched_barrier(0)
    Unit cur, nxt; int ui = 0;
    if (!S.next(0, cur)) return;
    f32x4 acc[2][2][4][2];
#pragma unroll
    for (int a = 0; a < 2; ++a)
#pragma unroll
        for (int b = 0; b < 2; ++b)
#pragma unroll
            for (int m = 0; m < 4; ++m)
#pragma unroll
                for (int n = 0; n < 2; ++n) acc[a][b][m][n] = (f32x4){0.f, 0.f, 0.f, 0.f};
    bf16x8 At[4][2], B0[2][2], B1[2][2];
    const char* cA = (const char*)g.A + (size_t)cur.pm * tstep; const char* cB = (const char*)g.Bt + (size_t)cur.pn * tstep;
    S.a_ready(cur);
    if constexpr (SP2) {
        PG8_STAGE(PG8_SB(0, 0), cB, voffB); PG8_STAGE(PG8_SB(0, 1), cB + hstep, voffB); PG8_STAGE(PG8_SA(0, 0), cA, voffA); PG8_STAGE(PG8_SA(0, 1), cA + hstep, voffA);
        if (wr == 1) PG8_BAR;
        PG8_WAIT_V(2); PG8_BAR;
        PG8_STAGE(PG8_SB(1, 0), cB + kstep, voffB); PG8_STAGE(PG8_SA(1, 0), cA + kstep, voffA); PG8_STAGE(PG8_SB(1, 1), cB + hstep + kstep, voffB);
        PG8_WAIT_V(6); PG8_BAR;
    } else {
        PG8_STAGE(PG8_SB(0, 0), cB, voffB); PG8_STAGE(PG8_SA(0, 0), cA, voffA); PG8_STAGE(PG8_SB(0, 1), cB + hstep, voffB); PG8_STAGE(PG8_SA(0, 1), cA + hstep, voffA);
        if (wr == 1) PG8_BAR;
        PG8_WAIT_V(4); PG8_BAR;
        PG8_STAGE(PG8_SB(1, 0), cB + kstep, voffB); PG8_STAGE(PG8_SA(1, 0), cA + kstep, voffA); PG8_STAGE(PG8_SB(1, 1), cB + hstep + kstep, voffB);
        PG8_WAIT_V(6); PG8_BAR;
    }
    for (;;) {
        const bool has_next = S.next(ui + 1, nxt);
        const char* nA = has_next ? (const char*)g.A + (size_t)nxt.pm * tstep : cA; const char* nB = has_next ? (const char*)g.Bt + (size_t)nxt.pn * tstep : cB;
        for (int t = 0; t < nt; t += 2) {
            const bool last = (t == nt - 2);
            const char* a1 = cA + (size_t)(t + 1) * kstep;
            const char* a2 = last ? nA : cA + (size_t)(t + 2) * kstep; const char* b2 = last ? nB : cB + (size_t)(t + 2) * kstep;
            const char* a3 = a2 + kstep; const char* b3 = b2 + kstep;
            if (last && has_next) S.a_ready(nxt);
            if constexpr (SP2) {
            PG8_LDB(B0, 0, 0); PG8_LDB(B1, 0, 1); PG8_SCHED; PG8_LDA(At, 0, 0); PG8_STAGE(PG8_SA(1, 1), a1 + hstep, voffA);
            PG8_WAIT_V(8); PG8_WAIT_L(0); PG8_BAR; PG8_MMA(0, 0, At, B0); PG8_MMA(0, 1, At, B1); PG8_BAR; PG8_SCHED;
            PG8_LDA(At, 0, 1); PG8_STAGE(PG8_SB(0, 0), b2, voffB); PG8_STAGE(PG8_SB(0, 1), b2 + hstep, voffB); PG8_STAGE(PG8_SA(0, 0), a2, voffA);
            PG8_WAIT_V(8); PG8_WAIT_L(0); PG8_BAR; PG8_MMA(1, 0, At, B0); PG8_MMA(1, 1, At, B1); PG8_BAR; PG8_SCHED;
            PG8_LDB(B0, 1, 0); PG8_LDB(B1, 1, 1); PG8_SCHED; PG8_LDA(At, 1, 0); PG8_STAGE(PG8_SA(0, 1), a2 + hstep, voffA);
            PG8_WAIT_V(8); PG8_WAIT_L(0); PG8_BAR; PG8_MMA(0, 0, At, B0); PG8_MMA(0, 1, At, B1); PG8_BAR; PG8_SCHED;
            PG8_LDA(At, 1, 1); PG8_STAGE(PG8_SB(1, 0), b3, voffB); PG8_STAGE(PG8_SB(1, 1), b3 + hstep, voffB); PG8_STAGE(PG8_SA(1, 0), a3, voffA);
            PG8_WAIT_V(8); PG8_WAIT_L(0); PG8_BAR; PG8_MMA(1, 0, At, B0); PG8_MMA(1, 1, At, B1); PG8_BAR; PG8_SCHED;
            } else {
            PG8_LDB(B0, 0, 0); PG8_SCHED; PG8_LDA(At, 0, 0); PG8_STAGE(PG8_SA(1, 1), a1 + hstep, voffA);
            PG8_WAIT_L(8); PG8_BAR; PG8_WAIT_L(0); PG8_MMA(0, 0, At, B0); PG8_BAR; PG8_SCHED;
            PG8_LDB(B1, 0, 1); PG8_STAGE(PG8_SB(0, 0), b2, voffB);
            PG8_BAR; PG8_WAIT_L(0); PG8_MMA(0, 1, At, B1); PG8_BAR;
            PG8_LDA(At, 0, 1); PG8_STAGE(PG8_SA(0, 0), a2, voffA);
            PG8_BAR; PG8_WAIT_L(0); PG8_MMA(1, 0, At, B0); PG8_BAR; PG8_SCHED;
            PG8_STAGE(PG8_SB(0, 1), b2 + hstep, voffB);
            PG8_WAIT_V(6); PG8_BAR; PG8_MMA(1, 1, At, B1); PG8_BAR;
            PG8_LDB(B0, 1, 0); PG8_SCHED; PG8_LDA(At, 1, 0); PG8_STAGE(PG8_SA(0, 1), a2 + hstep, voffA);
            PG8_WAIT_L(8); PG8_BAR; PG8_WAIT_L(0); PG8_MMA(0, 0, At, B0); PG8_BAR; PG8_SCHED;
            PG8_LDB(B1, 1, 1); PG8_STAGE(PG8_SB(1, 0), b3, voffB);
            PG8_BAR; PG8_WAIT_L(0); PG8_MMA(0, 1, At, B1); PG8_BAR;
            PG8_LDA(At, 1, 1); PG8_STAGE(PG8_SA(1, 0), a3, voffA);
            PG8_BAR; PG8_WAIT_L(0); PG8_MMA(1, 0, At, B0); PG8_BAR; PG8_SCHED;
            PG8_STAGE(PG8_SB(1, 1), b3 + hstep, voffB);
            PG8_WAIT_V(6); PG8_BAR; PG8_MMA(1, 1, At, B1); PG8_BAR;
            }
        }
        if constexpr (ALIGN_EPI) { if (wr == 0) PG8_BAR; }
        if constexpr (!Epi::AFTER_DRAIN) { E(acc, cur, wr, wc, fr, fq); S.done(cur); }
        if (!has_next) break;
#pragma unroll
        for (int a = 0; a < 2; ++a)
#pragma unroll
            for (int b = 0; b < 2; ++b)
#pragma unroll
                for (int m = 0; m < 4; ++m)
#pragma unroll
                    for (int n = 0; n < 2; ++n) acc[a][b][m][n] = (f32x4){0.f, 0.f, 0.f, 0.f};
        cur = nxt; cA = nA; cB = nB; ++ui;
        if constexpr (ALIGN_EPI) { if (wr == 1) PG8_BAR; }
    }
    PG8_WAIT_V(0);
    if constexpr (!ALIGN_EPI) { if (wr == 0) PG8_BAR; }
    PG8_BAR;
    if constexpr (Epi::AFTER_DRAIN) { E.fused(acc, cur, wr, wc, fr, fq, lds, wid, lane); S.done(cur); }
#undef PG8_SA
#undef PG8_SB
#undef PG8_STAGE
#undef PG8_LDA
#undef PG8_LDB
#undef PG8_MMA
#undef PG8_WAIT_V
#undef PG8_WAIT_L
#undef PG8_BAR
#undef PG8_SCHED
}
}

namespace pg8 {
typedef unsigned u32x2 __attribute__((ext_vector_type(2)));
constexpr float LOG2E = 1.4426950408889634f;
constexpr float C2 = 0.125f * 1.4426950408889634f;
__device__ __forceinline__ float bf_lo(unsigned w) { return __uint_as_float(w << 16); }
__device__ __forceinline__ float bf_hi(unsigned w) { return __uint_as_float(w & 0xffff0000u); }
__device__ __forceinline__ float sigmoid_f(float x) { return __builtin_amdgcn_rcpf(1.0f + __builtin_amdgcn_exp2f(-x * LOG2E)); }

struct EpiProj {
    static constexpr bool PERM = true, AFTER_DRAIN = false;
    bf16_t *QA, *QB, *QC, *GT; const float* rs; const float* ropec; const float* ropes;
    __device__ __forceinline__ void operator()(const f32x4 (&acc)[2][2][4][2], const Unit& u, int wr, int wc, int fr, int fq) const {
        const int pn = u.pn; bf16_t* base; int ldc, colt, mode; float sc = 1.f;
        if (pn < 6)       { base = QA; ldc = 1536; colt = pn * 256;        mode = 0;                if (pn < 2)  sc = C2; }
        else if (pn < 12) { base = QB; ldc = 1536; colt = (pn - 6) * 256;  mode = (pn < 10) ? 1 : 0; if (pn < 8)  sc = C2; }
        else if (pn < 21) { base = QC; ldc = 2304; colt = (pn - 12) * 256; mode = (pn < 18) ? 1 : 0; if (pn < 15) sc = C2; }
        else              { base = GT; ldc = 3072; colt = (pn - 21) * 256; mode = 2; }
        const int row0 = u.pm * BM + wr * 64 + fr, col0 = colt + wc * 32 + 8 * fq;
        const bool ropew = (mode == 1) && ((wc & 1) == 0);
#pragma unroll
        for (int ai = 0; ai < 2; ++ai)
#pragma unroll
            for (int m = 0; m < 4; ++m) {
                const int row = row0 + ai * HALF + m * 16; const float r = rs[row] * sc;
                f32x4 c0 = {1.f, 1.f, 1.f, 1.f}, c1 = c0, s0 = {0.f, 0.f, 0.f, 0.f}, s1 = s0;
                if (ropew) { const int t = row & 4095; c0 = *(const f32x4*)(ropec + t * 8); c1 = *(const f32x4*)(ropec + t * 8 + 4); s0 = *(const f32x4*)(ropes + t * 8); s1 = *(const f32x4*)(ropes + t * 8 + 4);
                    if (fq == 0) { s0 = -s0; s1 = -s1; } if (fq >= 2) { c0 = (f32x4){1.f, 1.f, 1.f, 1.f}; c1 = c0; s0 = (f32x4){0.f, 0.f, 0.f, 0.f}; s1 = s0; } }
                bf16_t* rowp = base + (size_t)row * ldc + col0;
#pragma unroll
                for (int bj = 0; bj < 2; ++bj) {
                    f32x4 v0 = acc[ai][bj][m][0] * r, v1 = acc[ai][bj][m][1] * r;
                    if (ropew) {
                        f32x4 p0, p1;
#pragma unroll
                        for (int j = 0; j < 4; ++j) { p0[j] = __shfl_xor(v0[j], 16); p1[j] = __shfl_xor(v1[j], 16); }
                        v0 = v0 * c0 + p0 * s0; v1 = v1 * c1 + p1 * s1;
                    }
                    if (mode == 2) {
#pragma unroll
                        for (int j = 0; j < 4; ++j) { v0[j] = sigmoid_f(v0[j]); v1[j] = sigmoid_f(v1[j]); }
                    }
                    u32x4 w; w.x = cvt_pk_bf16(v0[0], v0[1]); w.y = cvt_pk_bf16(v0[2], v0[3]); w.z = cvt_pk_bf16(v1[0], v1[1]); w.w = cvt_pk_bf16(v1[2], v1[3]);
                    *(u32x4*)(rowp + bj * HALF) = w;
                }
            }
    }
};

template <bool FIRST> struct EpiGate {
    static constexpr bool PERM = true, AFTER_DRAIN = false;
    bf16_t* MG; const bf16_t* GT; int gcol;
    __device__ __forceinline__ void operator()(const f32x4 (&acc)[2][2][4][2], const Unit& u, int wr, int wc, int fr, int fq) const {
        const int row0 = u.pm * BM + wr * 64 + fr, col0 = u.pn * BM + wc * 32 + 8 * fq;
#pragma unroll
        for (int ai = 0; ai < 2; ++ai)
#pragma unroll
            for (int m = 0; m < 4; ++m) {
                const int row = row0 + ai * HALF + m * 16;
#pragma unroll
                for (int bj = 0; bj < 2; ++bj) {
                    const int col = col0 + bj * HALF;
                    const u32x4 g = *(const u32x4*)(GT + (size_t)row * 3072 + gcol + col);
                    f32x4 v0 = acc[ai][bj][m][0], v1 = acc[ai][bj][m][1];
                    v0[0] *= bf_lo(g.x); v0[1] *= bf_hi(g.x); v0[2] *= bf_lo(g.y); v0[3] *= bf_hi(g.y);
                    v1[0] *= bf_lo(g.z); v1[1] *= bf_hi(g.z); v1[2] *= bf_lo(g.w); v1[3] *= bf_hi(g.w);
                    bf16_t* op = MG + (size_t)row * 1024 + col;
                    if (!FIRST) { const u32x4 o = *(const u32x4*)op;
                        v0[0] += bf_lo(o.x); v0[1] += bf_hi(o.x); v0[2] += bf_lo(o.y); v0[3] += bf_hi(o.y);
                        v1[0] += bf_lo(o.z); v1[1] += bf_hi(o.z); v1[2] += bf_lo(o.w); v1[3] += bf_hi(o.w); }
                    u32x4 w; w.x = cvt_pk_bf16(v0[0], v0[1]); w.y = cvt_pk_bf16(v0[2], v0[3]); w.z = cvt_pk_bf16(v1[0], v1[1]); w.w = cvt_pk_bf16(v1[2], v1[3]);
                    *(u32x4*)op = w;
                }
            }
    }
};

struct EpiResid {
    static constexpr bool PERM = false, AFTER_DRAIN = false;
    const float* base; float* out; int ldc;
    __device__ __forceinline__ void operator()(const f32x4 (&acc)[2][2][4][2], const Unit& u, int wr, int wc, int fr, int fq) const {
        const int row0 = u.pm * BM + wr * 64 + fr, col0 = u.pn * BM + wc * 32 + 4 * fq;
#pragma unroll
        for (int ai = 0; ai < 2; ++ai)
#pragma unroll
            for (int m = 0; m < 4; ++m) { const size_t off = (size_t)(row0 + ai * HALF + m * 16) * ldc + col0;
#pragma unroll
                for (int bj = 0; bj < 2; ++bj)
#pragma unroll
                    for (int n = 0; n < 2; ++n) { const f32x4 b = *(const f32x4*)(base + off + bj * HALF + n * 16); *(f32x4*)(out + off + bj * HALF + n * 16) = b + acc[ai][bj][m][n]; } }
    }
};

struct MoeOrder {
    const PG8_LAS int* tab; const unsigned* list; int G, c;
    __device__ __forceinline__ bool next(int i, Unit& u) const {
        const int L = i * G + c, tile = L >> 2; if (tile >= __builtin_amdgcn_readfirstlane(tab[16])) return false;
        int e = 0, base = 0;
#pragma unroll
        for (int j = 1; j < 16; ++j) { const int t = tab[j]; if (tile >= t) { e = j; base = t; } }
        e = __builtin_amdgcn_readfirstlane(e); base = __builtin_amdgcn_readfirstlane(base);
        u.pm = tile; u.pn = e * 4 + (L & 3); u.e = e; u.rt = tile - base; u.cnt = __builtin_amdgcn_readfirstlane(tab[17 + e]); return true;
    }
    __device__ __forceinline__ unsigned a_row(const Unit& u, int r) const { const int idx = u.rt * 256 + r; return (idx < u.cnt) ? (list[u.e * 16384 + idx] >> 1) : 0u; }
    __device__ __forceinline__ void a_ready(const Unit&) const {}
    __device__ __forceinline__ void done(const Unit&) const {}
};
struct EpiSwiglu {
    static constexpr bool PERM = false, AFTER_DRAIN = false;
    bf16_t* H1; const float* rs; const unsigned* list;
    __device__ __forceinline__ void operator()(const f32x4 (&acc)[2][2][4][2], const Unit& u, int wr, int wc, int fr, int fq) const {
        const int q = u.pn & 3; const int r0 = wr * 64 + fr, j0 = 128 * q + 16 * wc + 4 * fq;
#pragma unroll
        for (int ai = 0; ai < 2; ++ai)
#pragma unroll
            for (int m = 0; m < 4; ++m) {
                const int rl = r0 + ai * HALF + m * 16, idx = u.rt * 256 + rl; const bool ok = idx < u.cnt;
                const unsigned tok = ok ? (list[u.e * 16384 + idx] >> 1) : 0u; const float r = rs[tok];
#pragma unroll
                for (int bj = 0; bj < 2; ++bj) {
                    const f32x4 a1 = acc[ai][bj][m][0] * r, a3 = acc[ai][bj][m][1] * r; f32x4 hv;
#pragma unroll
                    for (int j = 0; j < 4; ++j) hv[j] = a1[j] * sigmoid_f(a1[j]) * a3[j];
                    u32x2 w; w.x = cvt_pk_bf16(hv[0], hv[1]); w.y = cvt_pk_bf16(hv[2], hv[3]);
                    if (ok) *(u32x2*)(H1 + (size_t)(u.pm * BM + rl) * 512 + j0 + 64 * bj) = w;
                }
            }
    }
};
struct EpiMoeOut {
    static constexpr bool PERM = true, AFTER_DRAIN = false;
    bf16_t* CB; const float* comb; const unsigned* list;
    __device__ __forceinline__ void operator()(const f32x4 (&acc)[2][2][4][2], const Unit& u, int wr, int wc, int fr, int fq) const {
        const int r0 = wr * 64 + fr, col0 = (u.pn & 3) * BM + wc * 32 + 8 * fq;
#pragma unroll
        for (int ai = 0; ai < 2; ++ai)
#pragma unroll
            for (int m = 0; m < 4; ++m) {
                const int rl = r0 + ai * HALF + m * 16, idx = u.rt * 256 + rl; const bool ok = idx < u.cnt;
                const unsigned ent = ok ? list[u.e * 16384 + idx] : 0u; const float cw = comb[(size_t)(ent >> 1) * 16 + u.e];
#pragma unroll
                for (int bj = 0; bj < 2; ++bj) {
                    const f32x4 v0 = acc[ai][bj][m][0] * cw, v1 = acc[ai][bj][m][1] * cw;
                    u32x4 w; w.x = cvt_pk_bf16(v0[0], v0[1]); w.y = cvt_pk_bf16(v0[2], v0[3]); w.z = cvt_pk_bf16(v1[0], v1[1]); w.w = cvt_pk_bf16(v1[2], v1[3]);
                    if (ok) *(u32x4*)(CB + (size_t)ent * 1024 + col0 + bj * HALF) = w;
                }
            }
    }
};
}

namespace pg8 {
template <class Epi, class Sched>
__device__ __forceinline__ void gemm_phase_g(PG8_LAS unsigned char* lds, const Gemm g, const Sched& S, const Epi& E) {
    const int tid = opq_tid(), wid = __builtin_amdgcn_readfirstlane(tid >> 6), lane = tid & 63, wr = wid >> 2, wc = wid & 3, fr = lane & 15, fq = lane >> 4;
    const int K = g.K, nt = K / BK;
    unsigned voffB[2]; int RA[2], CA[2];
#pragma unroll
    for (int i = 0; i < 2; ++i) { int R, C; stage_rc(tid * 16 + i * 8192, R, C); const int Rb = Epi::PERM ? ((R & ~31) + perm32(R & 31)) : R;
        RA[i] = R; CA[i] = C; voffB[i] = (unsigned)(Rb * K + C) * 2u; }
    const size_t kstep = (size_t)(BK * 2);
    const size_t hstep = (size_t)HALF * K * 2;
    const size_t tstep = 2 * hstep;
    const unsigned ldsw = (unsigned)wid * 1024u;
    const int aoff = lds_byte(wr * 64 + fr, fq * 8), boff = lds_byte(wc * 32 + fr, fq * 8);
#define PG8_SA(b, h) (((b) * 2 + (h)) * HTB)
#define PG8_SB(b, h) ((4 + (b) * 2 + (h)) * HTB)
#define PG8_STAGE(bufoff, gbase, voff) do { _Pragma("unroll") for (int _i = 0; _i < 2; ++_i) \
        __builtin_amdgcn_global_load_lds((const unsigned*)((const char*)(gbase) + (voff)[_i]), (PG8_LAS unsigned*)(lds + (bufoff) + ldsw + _i * 8192), 16, 0, 0); } while (0)
#define PG8_LDA(dst, b, h) do { _Pragma("unroll") for (int m = 0; m < 4; ++m) _Pragma("unroll") for (int k = 0; k < 2; ++k) dst[m][k] = *(const PG8_LAS bf16x8*)(lds + PG8_SA(b, h) + aoff + m * 2048 + k * 1024); } while (0)
#define PG8_LDB(dst, b, h) do { _Pragma("unroll") for (int n = 0; n < 2; ++n) _Pragma("unroll") for (int k = 0; k < 2; ++k) dst[n][k] = *(const PG8_LAS bf16x8*)(lds + PG8_SB(b, h) + boff + n * 2048 + k * 1024); } while (0)
#define PG8_MMA(ai, bj, At, Bt) do { __builtin_amdgcn_s_setprio(1); _Pragma("unroll") for (int m = 0; m < 4; ++m) _Pragma("unroll") for (int n = 0; n < 2; ++n) _Pragma("unroll") for (int k = 0; k < 2; ++k) \
        acc[ai][bj][m][n] = __builtin_amdgcn_mfma_f32_16x16x32_bf16(Bt[n][k], At[m][k], acc[ai][bj][m][n], 0, 0, 0); __builtin_amdgcn_s_setprio(0); } while (0)
#define PG8_WAIT_V(n) asm volatile("s_waitcnt vmcnt(" #n ")" ::: "memory")
#define PG8_WAIT_L(n) asm volatile("s_waitcnt lgkmcnt(" #n ")" ::: "memory")
#define PG8_BAR __builtin_amdgcn_s_barrier()
#define PG8_SCHED __builtin_amdgcn_sched_barrier(0)
#define PG8_AOFFS(dst, u) do { _Pragma("unroll") for (int _h = 0; _h < 2; ++_h) _Pragma("unroll") for (int _i = 0; _i < 2; ++_i) \
        dst[_h][_i] = (unsigned)(S.a_row((u), _h * HALF + RA[_i]) * (unsigned)K + (unsigned)CA[_i]) * 2u; } while (0)
    Unit cur, nxt; int ui = 0;
    if (!S.next(0, cur)) return;
    f32x4 acc[2][2][4][2];
#pragma unroll
    for (int a = 0; a < 2; ++a)
#pragma unroll
        for (int b = 0; b < 2; ++b)
#pragma unroll
            for (int m = 0; m < 4; ++m)
#pragma unroll
                for (int n = 0; n < 2; ++n) acc[a][b][m][n] = (f32x4){0.f, 0.f, 0.f, 0.f};
    bf16x8 At[4][2], B0[2][2], B1[2][2];
    unsigned vc[2][2], vn[2][2];
    PG8_AOFFS(vc, cur);
    const char* const gA = (const char*)g.A;
    const char* cB = (const char*)g.Bt + (size_t)cur.pn * tstep;
    S.a_ready(cur);
    PG8_STAGE(PG8_SB(0, 0), cB, voffB); PG8_STAGE(PG8_SB(0, 1), cB + hstep, voffB); PG8_STAGE(PG8_SA(0, 0), gA, vc[0]); PG8_STAGE(PG8_SA(0, 1), gA, vc[1]);
    if (wr == 1) PG8_BAR;
    PG8_WAIT_V(2); PG8_BAR;
    PG8_STAGE(PG8_SB(1, 0), cB + kstep, voffB); PG8_STAGE(PG8_SA(1, 0), gA + kstep, vc[0]); PG8_STAGE(PG8_SB(1, 1), cB + hstep + kstep, voffB);
    PG8_WAIT_V(6); PG8_BAR;
    for (;;) {
        const bool has_next = S.next(ui + 1, nxt);
        if (has_next) { PG8_AOFFS(vn, nxt); } else {
#pragma unroll
            for (int _h = 0; _h < 2; ++_h)
#pragma unroll
                for (int _i = 0; _i < 2; ++_i) vn[_h][_i] = vc[_h][_i]; }
        const char* nB = has_next ? (const char*)g.Bt + (size_t)nxt.pn * tstep : cB;
        for (int t = 0; t < nt; t += 2) {
            const bool last = (t == nt - 2);
            const char* a1 = gA + (size_t)(t + 1) * kstep;
            const char* a2 = last ? gA : gA + (size_t)(t + 2) * kstep; const char* b2 = last ? nB : cB + (size_t)(t + 2) * kstep;
            const char* a3 = a2 + kstep; const char* b3 = b2 + kstep;
            unsigned v2[2][2];
#pragma unroll
            for (int _h = 0; _h < 2; ++_h)
#pragma unroll
                for (int _i = 0; _i < 2; ++_i) v2[_h][_i] = last ? vn[_h][_i] : vc[_h][_i];
            if (last && has_next) S.a_ready(nxt);
            PG8_LDB(B0, 0, 0); PG8_LDB(B1, 0, 1); PG8_SCHED; PG8_LDA(At, 0, 0); PG8_STAGE(PG8_SA(1, 1), a1, vc[1]);
            PG8_WAIT_V(8); PG8_WAIT_L(0); PG8_BAR; PG8_MMA(0, 0, At, B0); PG8_MMA(0, 1, At, B1); PG8_BAR; PG8_SCHED;
            PG8_LDA(At, 0, 1); PG8_STAGE(PG8_SB(0, 0), b2, voffB); PG8_STAGE(PG8_SB(0, 1), b2 + hstep, voffB); PG8_STAGE(PG8_SA(0, 0), a2, v2[0]);
            PG8_WAIT_V(8); PG8_WAIT_L(0); PG8_BAR; PG8_MMA(1, 0, At, B0); PG8_MMA(1, 1, At, B1); PG8_BAR; PG8_SCHED;
            PG8_LDB(B0, 1, 0); PG8_LDB(B1, 1, 1); PG8_SCHED; PG8_LDA(At, 1, 0); PG8_STAGE(PG8_SA(0, 1), a2, v2[1]);
            PG8_WAIT_V(8); PG8_WAIT_L(0); PG8_BAR; PG8_MMA(0, 0, At, B0); PG8_MMA(0, 1, At, B1); PG8_BAR; PG8_SCHED;
            PG8_LDA(At, 1, 1); PG8_STAGE(PG8_SB(1, 0), b3, voffB); PG8_STAGE(PG8_SB(1, 1), b3 + hstep, voffB); PG8_STAGE(PG8_SA(1, 0), a3, v2[0]);
            PG8_WAIT_V(8); PG8_WAIT_L(0); PG8_BAR; PG8_MMA(1, 0, At, B0); PG8_MMA(1, 1, At, B1); PG8_BAR; PG8_SCHED;
        }
        if (wr == 0) PG8_BAR;
        E(acc, cur, wr, wc, fr, fq); S.done(cur);
        if (!has_next) break;
#pragma unroll
        for (int a = 0; a < 2; ++a)
#pragma unroll
            for (int b = 0; b < 2; ++b)
#pragma unroll
                for (int m = 0; m < 4; ++m)
#pragma unroll
                    for (int n = 0; n < 2; ++n) acc[a][b][m][n] = (f32x4){0.f, 0.f, 0.f, 0.f};
        cur = nxt; cB = nB; ++ui;
#pragma unroll
        for (int _h = 0; _h < 2; ++_h)
#pragma unroll
            for (int _i = 0; _i < 2; ++_i) vc[_h][_i] = vn[_h][_i];
        if (wr == 1) PG8_BAR;
    }
    PG8_WAIT_V(0);
    PG8_BAR;
#undef PG8_SA
#undef PG8_SB
#undef PG8_STAGE
#undef PG8_LDA
#undef PG8_LDB
#undef PG8_MMA
#undef PG8_WAIT_V
#undef PG8_WAIT_L
#undef PG8_BAR
#undef PG8_SCHED
#undef PG8_AOFFS
}
}

constexpr int NTOK = 16384, DM = 1024, SEQ = 4096, DEPTH = 4, INW = 8448;
constexpr int NWAVES = 8;
constexpr int N_PHASES = 1 + 8 * DEPTH;
#ifndef MK_ONE_LAUNCH
#define MK_ONE_LAUNCH 0
#endif
constexpr size_t MiB = 1u << 20;
constexpr size_t WS_CTL = 0, CTL_ZERO_BYTES = 1 * MiB;
constexpr size_t WS_RS1 = 1 * MiB, WS_RS2 = WS_RS1 + 65536, WS_ROPEC = WS_RS2 + 65536, WS_ROPES = WS_ROPEC + 131072;
constexpr size_t WS_LSE = 2 * MiB;
constexpr size_t WS_COMB = 3 * MiB;
constexpr size_t WS_WIN = 4 * MiB, WS_WPA = 21 * MiB, WS_WPB = 22 * MiB, WS_WPC = 23 * MiB, WS_WO = 24 * MiB, WS_W13 = 26 * MiB, WS_W2 = 58 * MiB;
constexpr size_t WS_ABF = 74 * MiB;
constexpr size_t WS_QA = 106 * MiB, WS_QB = 154 * MiB, WS_QC = 202 * MiB, WS_GATE = 274 * MiB;
constexpr size_t WS_H1 = 106 * MiB;
constexpr size_t WS_CB = 146 * MiB;
constexpr size_t WS_YA = 370 * MiB, WS_YB = 386 * MiB, WS_YC = 402 * MiB, WS_OC = 410 * MiB, WS_STASH = 434 * MiB, WS_MERGED = 466 * MiB, WS_LIST = 498 * MiB, WS_RT = 499 * MiB  , WS_WSET1 = 500 * MiB  , WS_END = 570 * MiB;
constexpr size_t WSET_STRIDE = WS_WSET1 - 4 * MiB;
static_assert(WS_H1 + (size_t)36864 * 512 * 2 <= WS_CB && WS_CB + (size_t)2 * NTOK * 1024 * 2 <= WS_YA, "MoE overlays");
constexpr int CW_BAR = 4096, CW_CNT = 8192, CW_QHEAD = 12288  , CW_DONE = 12800  ;
constexpr int CONV_ITEMS = 16 * 264 + 2 * 8 * 32 + 4 * 32 + 16 * 32 + 16 * 512 + 16 * 256;
constexpr int RING_BYTES = 131072, LDSCTL_OFF = RING_BYTES, MISC_OFF = LDSCTL_OFF + 320, LDS_BYTES = 147456;

#define GAS __attribute__((address_space(1)))
#define LAS __attribute__((address_space(3)))
typedef unsigned short bf16;
typedef unsigned v4u __attribute__((ext_vector_type(4)));
typedef unsigned v2u __attribute__((ext_vector_type(2)));
typedef float f32x4 __attribute__((ext_vector_type(4)));
typedef float f32x16 __attribute__((ext_vector_type(16)));
typedef short bf16x8 __attribute__((ext_vector_type(8)));
typedef short s16x4 __attribute__((ext_vector_type(4)));
#define LDS_WAIT() asm volatile("s_waitcnt lgkmcnt(0)" ::: "memory")
#define VM_WAIT() asm volatile("s_waitcnt vmcnt(0)" ::: "memory")
using pg8::cvt_pk_bf16;
using pg8::LOG2E;
__device__ __forceinline__ float wave_sum(float v) {
#pragma unroll
    for (int o = 1; o < 64; o <<= 1) v += __shfl_xor(v, o);
    return v;
}
__device__ __forceinline__ s16x4 vtr(const LAS unsigned char* p) { return __builtin_bit_cast(s16x4, __builtin_amdgcn_ds_read_tr16_b64_v4i16((LAS s16x4*)p)); }

#define XB_TMO      128
#define XB_XCNT(j)  (256  + 64 * (j))
#define XB_XSUB(j)  (1280 + 64 * (j))
#define XB_XGEN(j)  (2304 + 64 * (j))
#define XB_TOP      3328
#define XB_TOPGEN   3392
#define XCD_BAR_WORDS 3456
#define XB_SPIN_CAP (1u << 18)

__device__ __forceinline__ unsigned xb_ld(unsigned* p)              { return __hip_atomic_load(p, __ATOMIC_RELAXED, __HIP_MEMORY_SCOPE_AGENT); }
__device__ __forceinline__ unsigned xb_add(unsigned* p, unsigned v) { return __hip_atomic_fetch_add(p, v, __ATOMIC_RELAXED, __HIP_MEMORY_SCOPE_AGENT); }
__device__ __forceinline__ unsigned xb_xcc_id() { return (unsigned)__builtin_amdgcn_s_getreg((3 << 11) | 20) & 0xFu; }
#define XB_SPIN(cond, bar) do { unsigned _sp = 0; while (cond) { __builtin_amdgcn_s_sleep(1); \
    if ((++_sp & 255u) == 0u) { if (xb_ld(&(bar)[XB_TMO])) break; if (_sp > XB_SPIN_CAP) { atomicAdd(&(bar)[XB_TMO], 1u); break; } } } } while (0)

struct XcdBarrier {
    unsigned* bar; unsigned x;
    volatile LAS unsigned* st;
};

__device__ __forceinline__ XcdBarrier xcd_barrier_post(unsigned* bar, volatile LAS unsigned* st) {
    XcdBarrier b; b.bar = bar; b.x = xb_xcc_id(); b.st = st;
    if (threadIdx.x == 0) (void)xb_add(&bar[XB_XCNT(b.x)], 1u);
    return b;
}
__device__ __forceinline__ void xcd_barrier_complete(unsigned* bar, unsigned x, unsigned& nloc, unsigned& nx) {
    const unsigned G = gridDim.x * gridDim.y * gridDim.z;
    unsigned sum, cnt, mine, sp = 0u;
    for (;;) {
        sum = 0u; cnt = 0u; mine = 0u;
#pragma unroll
        for (unsigned j = 0; j < 16; ++j) { const unsigned c = xb_ld(&bar[XB_XCNT(j)]); sum += c; cnt += (c > 0u) ? 1u : 0u; mine = (j == x) ? c : mine; }
        if (sum == G) break;
        __builtin_amdgcn_s_sleep(1);
        if ((++sp & 255u) == 0u) { if (xb_ld(&bar[XB_TMO])) break; if (sp > XB_SPIN_CAP) { atomicAdd(&bar[XB_TMO], 1u); break; } }
    }
    nloc = mine > 0u ? mine : 1u; nx = cnt > 0u ? cnt : 1u;
}

__device__ __forceinline__ void xcd_barrier(const XcdBarrier& b) {
    asm volatile("s_waitcnt vmcnt(0)" ::: "memory");
    __syncthreads();
    if (threadIdx.x == 0) {
        unsigned* bar = b.bar;
        __builtin_amdgcn_s_waitcnt(0);
        unsigned nloc = b.st[0], nx = b.st[1];
        if (nloc == 0u) { xcd_barrier_complete(bar, b.x, nloc, nx); b.st[0] = nloc; b.st[1] = nx; }
        const unsigned old = xb_add(&bar[XB_XSUB(b.x)], 1u);
        const unsigned gen = old / nloc;
        if (old + 1u == (gen + 1u) * nloc) {
            __builtin_amdgcn_fence(__ATOMIC_RELEASE, "agent");
            asm volatile("s_waitcnt vmcnt(0)" ::: "memory");
            const unsigned og = xb_add(&bar[XB_TOP], 1u);
            const unsigned tg = og / nx;
            if (og + 1u == (tg + 1u) * nx) xb_add(&bar[XB_TOPGEN], 1u);
            else XB_SPIN(xb_ld(&bar[XB_TOPGEN]) == tg, bar);
            __builtin_amdgcn_fence(__ATOMIC_ACQUIRE, "agent");
            xb_add(&bar[XB_XGEN(b.x)], 1u);
            asm volatile("s_waitcnt vmcnt(0)" ::: "memory");
        } else {
            XB_SPIN(xb_ld(&bar[XB_XGEN(b.x)]) == gen, bar);
            __builtin_amdgcn_fence(__ATOMIC_ACQUIRE, "agent");
            asm volatile("s_waitcnt vmcnt(0)" ::: "memory");
        }
    }
    __syncthreads();
}

struct Frame {
    LAS unsigned char* lds;
    volatile LAS unsigned* MISC;
    unsigned* ctl;
    int tid, lane, wave, vcu, G, bx;
    const __attribute__((address_space(4))) unsigned char* ka;
    float* out; unsigned char* ws;
};
#define CAS __attribute__((address_space(4)))
#define INP(i) (*(const float* const CAS*)(F.ka + 8 * (i)))
#define WSP(T, off) ((T*)(F.ws + (off)))
#define WSW(off, l) ((bf16*)(F.ws + (off) + (size_t)((l) & 1) * WSET_STRIDE))

__device__ __forceinline__ void conv_item(const float* sp, int ld, const float* gp, bf16* dp, int dpitch, LAS float* scr, int lane) {
    const int kh = lane >> 5, nl = lane & 31;
    float tv[32];
#pragma unroll
    for (int i = 0; i < 32; ++i) tv[i] = sp[(size_t)(2 * i) * ld];
#pragma unroll
    for (int i = 0; i < 32; ++i) { const int kk = 2 * i + kh; float v = tv[i]; if (gp) v *= gp[kk]; scr[kk * 33 + nl] = v; }
    LDS_WAIT(); asm volatile("" ::: "memory");
    const int c = lane & 7;
#pragma unroll
    for (int j = 0; j < 4; ++j) { const int n = (lane >> 3) + 8 * j; const LAS float* s = scr + (8 * c) * 33 + n;
        v4u o; o.x = cvt_pk_bf16(s[0 * 33], s[1 * 33]); o.y = cvt_pk_bf16(s[2 * 33], s[3 * 33]); o.z = cvt_pk_bf16(s[4 * 33], s[5 * 33]); o.w = cvt_pk_bf16(s[6 * 33], s[7 * 33]);
        *(v4u*)(dp + (size_t)n * dpitch + 8 * c) = o; }
    LDS_WAIT(); asm volatile("" ::: "memory");
}
__device__ __forceinline__ void conv_one(Frame& F, int l, int it, LAS float* scr) {
    const int lane = F.lane, kh = lane >> 5, nl = lane & 31;
    const float* w_in = INP(1) + (size_t)l * DM * INW; const float* w_pa = INP(8) + (size_t)l * 512 * DM; const float* w_pb = INP(9) + (size_t)l * 512 * DM;
    const float* w_pc = INP(10) + (size_t)l * 256 * DM; const float* w_o = INP(11) + (size_t)l * DM * DM;
    const float* g1 = INP(12) + l * DM; const float* g2 = INP(13) + l * DM;
    const float* w1 = INP(18) + (size_t)l * 16 * DM * 512; const float* w3 = INP(19) + (size_t)l * 16 * DM * 512; const float* w2 = INP(20) + (size_t)l * 16 * 512 * DM;
    constexpr int I_IN = 16 * 264, I_PA = 8 * 32, I_PC = 4 * 32, I_O = 16 * 32, I_13 = 16 * 512, I_2 = 16 * 256;
    static_assert(CONV_ITEMS == I_IN + 2 * I_PA + I_PC + I_O + I_13 + I_2, "item count");
    {
        int r = it;
        if (r < I_IN) { const int kb = r / 264, nb = r % 264; conv_item(w_in + (size_t)(64 * kb + kh) * INW + 32 * nb + nl, INW, g1 + 64 * kb, WSW(WS_WIN, l) + (size_t)(32 * nb) * 1024 + 64 * kb, 1024, scr, lane); return; } r -= I_IN;
        if (r < I_PA) { const int kb = r / 32, nb = r % 32; conv_item(w_pa + (size_t)(64 * kb + kh) * DM + 32 * nb + nl, DM, nullptr, WSW(WS_WPA, l) + (size_t)(32 * nb) * 512 + 64 * kb, 512, scr, lane); return; } r -= I_PA;
        if (r < I_PA) { const int kb = r / 32, nb = r % 32; conv_item(w_pb + (size_t)(64 * kb + kh) * DM + 32 * nb + nl, DM, nullptr, WSW(WS_WPB, l) + (size_t)(32 * nb) * 512 + 64 * kb, 512, scr, lane); return; } r -= I_PA;
        if (r < I_PC) { const int kb = r / 32, nb = r % 32; conv_item(w_pc + (size_t)(64 * kb + kh) * DM + 32 * nb + nl, DM, nullptr, WSW(WS_WPC, l) + (size_t)(32 * nb) * 256 + 64 * kb, 256, scr, lane); return; } r -= I_PC;
        if (r < I_O)  { const int kb = r / 32, nb = r % 32; conv_item(w_o + (size_t)(64 * kb + kh) * DM + 32 * nb + nl, DM, nullptr, WSW(WS_WO, l) + (size_t)(32 * nb) * 1024 + 64 * kb, 1024, scr, lane); return; } r -= I_O;
        if (r < I_13) { const int e = r / 512, q = r % 512, kb = q / 32, nb = q % 32;
            const float* src = ((nl < 16) ? w1 : w3) + (size_t)e * DM * 512 + (size_t)(64 * kb + kh) * 512 + 16 * nb + (nl & 15);
            conv_item(src, 512, g2 + 64 * kb, WSW(WS_W13, l) + (size_t)(e * 1024 + 32 * nb) * 1024 + 64 * kb, 1024, scr, lane); return; } r -= I_13;
        { const int e = r / 256, q = r % 256, kb = q / 32, nb = q % 32;
            conv_item(w2 + (size_t)e * 512 * DM + (size_t)(64 * kb + kh) * DM + 32 * nb + nl, DM, nullptr, WSW(WS_W2, l) + (size_t)(e * 1024 + 32 * nb) * 512 + 64 * kb, 512, scr, lane); }
    }
}
__device__ __forceinline__ void conv_layer(Frame& F, int l) {
    LAS float* scr = (LAS float*)(F.lds + F.wave * 16384);
    const int gw = F.vcu * NWAVES + F.wave, NGW = F.G * NWAVES;
    for (int it = gw; it < CONV_ITEMS; it += NGW) conv_one(F, l, it, scr);
}
__device__ __forceinline__ void conv_fill(Frame& F, int l, const unsigned* donew) {
    LAS float* scr = (LAS float*)(F.lds + F.wave * 16384);
    unsigned* qh = F.ctl + CW_QHEAD + 64 * l;
    for (;;) {
        __syncthreads();
        if (F.tid == 0) { unsigned base = 0xffffffffu;
            if (__hip_atomic_load(donew, __ATOMIC_RELAXED, __HIP_MEMORY_SCOPE_AGENT) < (unsigned)F.G) base = __hip_atomic_fetch_add(qh, 8u, __ATOMIC_RELAXED, __HIP_MEMORY_SCOPE_AGENT);
            F.MISC[16] = base; }
        __syncthreads();
        const unsigned base = (unsigned)__builtin_amdgcn_readfirstlane((int)F.MISC[16]);
        if (base >= (unsigned)CONV_ITEMS) break;
        const unsigned it = base + F.wave;
        if (it < (unsigned)CONV_ITEMS) conv_one(F, l, (int)it, scr);
    }
}
__device__ __forceinline__ void conv_rest(Frame& F, int l) {
    LAS float* scr = (LAS float*)(F.lds + F.wave * 16384);
    const unsigned h0 = (unsigned)__builtin_amdgcn_readfirstlane((int)__hip_atomic_load(F.ctl + CW_QHEAD + 64 * l, __ATOMIC_RELAXED, __HIP_MEMORY_SCOPE_AGENT));
    const int gw = F.vcu * NWAVES + F.wave, NGW = F.G * NWAVES;
    for (unsigned it = h0 + gw; it < (unsigned)CONV_ITEMS; it += NGW) conv_one(F, l, (int)it, scr);
}
__device__ __forceinline__ void phase_done(Frame& F, int ph) { __syncthreads(); if (F.tid == 0) __hip_atomic_fetch_add(F.ctl + CW_DONE + 64 * ph, 1u, __ATOMIC_RELAXED, __HIP_MEMORY_SCOPE_AGENT); }
__device__ __forceinline__ void router_tables(Frame& F) {
    float* rt = WSP(float, WS_RT);
    for (int idx = F.bx * 512 + F.tid; idx < DEPTH * 20 * DM; idx += F.G * 512) { const int l = idx / (20 * DM), c = (idx / DM) % 20, k = idx % DM;
        rt[idx] = INP(13)[l * DM + k] * ((c < 4) ? INP(14)[((size_t)l * DM + k) * 4 + c] : INP(16)[((size_t)l * DM + k) * 16 + (c - 4)]); }
}
__device__ __forceinline__ void rope_tables(Frame& F) {
    const double inv[8] = {1.0, 0.19392274474868576, 0.03760603093086393, 0.007292664737217109, 0.001414213562373095, 0.0002742481756762073, 5.318295896944988e-05, 1.031338537721246e-05};
    float* rc = WSP(float, WS_ROPEC); float* rsn = WSP(float, WS_ROPES);
    for (int idx = F.bx * 512 + F.tid; idx < SEQ * 8; idx += F.G * 512) {
        const int t = idx >> 3, i = idx & 7;
        double f = 1.0; f = (i == 1) ? inv[1] : f; f = (i == 2) ? inv[2] : f; f = (i == 3) ? inv[3] : f; f = (i == 4) ? inv[4] : f; f = (i == 5) ? inv[5] : f; f = (i == 6) ? inv[6] : f; f = (i == 7) ? inv[7] : f;
        const double rev = (double)t * f * 0.15915494309189535;
        const float fr = (float)(rev - __builtin_rint(rev));
        rc[idx] = __builtin_amdgcn_cosf(fr); rsn[idx] = __builtin_amdgcn_sinf(fr);
    }
}
__device__ __forceinline__ f32x4 bf4(v2u w) { return (f32x4){pg8::bf_lo(w.x), pg8::bf_hi(w.x), pg8::bf_lo(w.y), pg8::bf_hi(w.y)}; }
__device__ __forceinline__ void norm_rows(Frame& F, const float* src, float* copy, float* rs, const bf16* cb) {
    const int gw = F.vcu * NWAVES + F.wave, NGW = F.G * NWAVES;
    bf16* abf = WSP(bf16, WS_ABF);
    for (int m0 = gw; m0 < NTOK; m0 += 4 * NGW) {
        f32x4 v[4][4];
#pragma unroll
        for (int q = 0; q < 4; ++q) { const f32x4* xr = (const f32x4*)(src + (size_t)(m0 + q * NGW) * DM) + F.lane;
#pragma unroll
            for (int j = 0; j < 4; ++j) v[q][j] = xr[64 * j]; }
        if (cb) { v2u c0[4][4], c1[4][4];
#pragma unroll
            for (int q = 0; q < 4; ++q) { const int m = m0 + q * NGW; const v2u* p0 = (const v2u*)(cb + (size_t)(2 * m) * DM) + F.lane; const v2u* p1 = (const v2u*)(cb + (size_t)(2 * m + 1) * DM) + F.lane;
#pragma unroll
                for (int j = 0; j < 4; ++j) { c0[q][j] = p0[64 * j]; c1[q][j] = p1[64 * j]; } }
#pragma unroll
            for (int q = 0; q < 4; ++q)
#pragma unroll
                for (int j = 0; j < 4; ++j) v[q][j] = (v[q][j] + bf4(c0[q][j])) + bf4(c1[q][j]); }
#pragma unroll
        for (int q = 0; q < 4; ++q) { const int m = m0 + q * NGW; float s = 0.f;
#pragma unroll
            for (int j = 0; j < 4; ++j) s += (v[q][j].x * v[q][j].x + v[q][j].y * v[q][j].y) + (v[q][j].z * v[q][j].z + v[q][j].w * v[q][j].w);
            const float r = 1.0f / sqrtf(wave_sum(s) * (1.0f / DM) + 1e-6f);
            if (F.lane == 0) rs[m] = r;
            v2u* o8 = (v2u*)(abf + (size_t)m * DM) + F.lane;
#pragma unroll
            for (int j = 0; j < 4; ++j) { v2u w; w.x = cvt_pk_bf16(v[q][j].x, v[q][j].y); w.y = cvt_pk_bf16(v[q][j].z, v[q][j].w); o8[64 * j] = w; }
            if (copy) { f32x4* c = (f32x4*)(copy + (size_t)m * DM) + F.lane;
#pragma unroll
                for (int j = 0; j < 4; ++j) c[64 * j] = v[q][j]; } }
    }
}
__device__ __forceinline__ void norm_route(Frame& F, int l, bool append) {
    const int gw = F.vcu * NWAVES + F.wave, NGW = F.G * NWAVES, lane = F.lane;
    LAS float* wt = (LAS float*)F.lds;
    const float* bg = INP(15) + l * 4; const float* be = INP(17) + l * 16;
    { const f32x4* rt = (const f32x4*)(WSP(float, WS_RT) + (size_t)l * 20 * DM); f32x4 tv[10];
#pragma unroll
      for (int i = 0; i < 10; ++i) tv[i] = rt[F.tid + 512 * i];
#pragma unroll
      for (int i = 0; i < 10; ++i) *(LAS f32x4*)(wt + 4 * (F.tid + 512 * i)) = tv[i]; }
    LAS unsigned* pe = (LAS unsigned*)(F.lds + 98304); LAS unsigned* pent = pe + 128; LAS unsigned* plp = pe + 256; LAS unsigned* lcount = pe + 384; LAS unsigned* lbase = pe + 400;
    if (F.tid < 16) lcount[F.tid] = 0u;
    __syncthreads();
    int jj = 0;
    float bias[20];
#pragma unroll
    for (int c = 0; c < 20; ++c) bias[c] = (c < 4) ? bg[c] : be[c - 4];
    bf16* abf = WSP(bf16, WS_ABF); float* rs = WSP(float, WS_RS2); float* comb = WSP(float, WS_COMB); const float* src = F.out;
    for (int m0 = gw; m0 < NTOK; m0 += 4 * NGW) {
      f32x4 vq[4][4];
#pragma unroll
      for (int q = 0; q < 4; ++q) { const f32x4* xr = (const f32x4*)(src + (size_t)(m0 + q * NGW) * DM) + lane;
#pragma unroll
          for (int j = 0; j < 4; ++j) vq[q][j] = xr[64 * j]; }
#pragma unroll
      for (int q = 0; q < 4; ++q) {
        const int m = m0 + q * NGW; f32x4 v[4]; float s = 0.f;
#pragma unroll
        for (int j = 0; j < 4; ++j) { v[j] = vq[q][j]; s += (v[j].x * v[j].x + v[j].y * v[j].y) + (v[j].z * v[j].z + v[j].w * v[j].w); }
        const float r = 1.0f / sqrtf(wave_sum(s) * (1.0f / DM) + 1e-6f);
        if (lane == 0) rs[m] = r;
        v2u* o8 = (v2u*)(abf + (size_t)m * DM) + lane;
#pragma unroll
        for (int j = 0; j < 4; ++j) { v2u w; w.x = cvt_pk_bf16(v[j].x, v[j].y); w.y = cvt_pk_bf16(v[j].z, v[j].w); o8[64 * j] = w; }
        float lg[20];
#pragma unroll
        for (int c = 0; c < 20; ++c) { float a = 0.f;
#pragma unroll
            for (int j = 0; j < 4; ++j) { const f32x4 w = *(const LAS f32x4*)(wt + c * 1024 + 256 * j + 4 * lane); a += (v[j].x * w.x + v[j].y * w.y) + (v[j].z * w.z + v[j].w * w.w); }
            lg[c] = wave_sum(a) * r + bias[c]; }
        int gs = 0; float gm = lg[0];
#pragma unroll
        for (int j = 1; j < 4; ++j) if (lg[j] > gm) { gm = lg[j]; gs = j; }
        float gden = 0.f;
#pragma unroll
        for (int j = 0; j < 4; ++j) gden += __builtin_amdgcn_exp2f((lg[j] - gm) * LOG2E);
        const float ggate = 1.0f / gden;
        float el[4];
#pragma unroll
        for (int j = 0; j < 4; ++j) el[j] = (gs == 0) ? lg[4 + j] : (gs == 1) ? lg[8 + j] : (gs == 2) ? lg[12 + j] : lg[16 + j];
        int t1 = 0; float v1 = el[0];
#pragma unroll
        for (int j = 1; j < 4; ++j) if (el[j] > v1) { v1 = el[j]; t1 = j; }
        int t2 = -1; float v2 = -3.0e38f;
#pragma unroll
        for (int j = 0; j < 4; ++j) if (j != t1 && el[j] > v2) { v2 = el[j]; t2 = j; }
        if (t2 < 0) t2 = (t1 == 0) ? 1 : 0;
        const float ex = __builtin_amdgcn_exp2f((v2 - v1) * LOG2E), w1 = ggate / (1.0f + ex), w2 = ggate * ex / (1.0f + ex);
        const int e1 = gs * 4 + t1, e2 = gs * 4 + t2;
        if (lane < 16) comb[(size_t)m * 16 + lane] = (lane == e1) ? w1 : (lane == e2) ? w2 : 0.f;
        if (lane < 2 && jj < 8) { const int e = (lane == 0) ? e1 : e2, slot = F.wave * 16 + jj * 2 + lane;
            pe[slot] = (unsigned)e; pent[slot] = (unsigned)(2 * m + lane); plp[slot] = __hip_atomic_fetch_add(lcount + e, 1u, __ATOMIC_RELAXED, __HIP_MEMORY_SCOPE_WORKGROUP); }
        ++jj;
      }
    }
    __syncthreads();
    unsigned* gcnt = F.ctl + CW_CNT + l * 1024; unsigned* list = WSP(unsigned, WS_LIST);
    if (F.tid < 16 && append) lbase[F.tid] = __hip_atomic_fetch_add(gcnt + 64 * F.tid, lcount[F.tid], __ATOMIC_RELAXED, __HIP_MEMORY_SCOPE_AGENT);
    __syncthreads();
    if (F.tid < 128 && append) { const unsigned e = pe[F.tid]; list[e * 16384 + lbase[e] + plp[F.tid]] = pent[F.tid]; }
    __syncthreads();
}
__device__ __forceinline__ void final_norm(Frame& F) {
    const int gw = F.vcu * NWAVES + F.wave, NGW = F.G * NWAVES; const float* gf = INP(21); const bf16* cb = WSP(bf16, WS_CB);
    f32x4 g[4];
#pragma unroll
    for (int j = 0; j < 4; ++j) g[j] = *((const f32x4*)gf + F.lane + 64 * j);
    for (int m = gw; m < NTOK; m += NGW) {
        f32x4* xr = (f32x4*)(F.out + (size_t)m * DM) + F.lane; f32x4 v[4]; float s = 0.f;
        const v2u* c0 = (const v2u*)(cb + (size_t)(2 * m) * DM) + F.lane; const v2u* c1 = (const v2u*)(cb + (size_t)(2 * m + 1) * DM) + F.lane;
#pragma unroll
        for (int j = 0; j < 4; ++j) { v[j] = (xr[64 * j] + bf4(c0[64 * j])) + bf4(c1[64 * j]); s += (v[j].x * v[j].x + v[j].y * v[j].y) + (v[j].z * v[j].z + v[j].w * v[j].w); }
        const float r = 1.0f / sqrtf(wave_sum(s) * (1.0f / DM) + 1e-6f);
#pragma unroll
        for (int j = 0; j < 4; ++j) xr[64 * j] = v[j] * r * g[j];
    }
}

#define MFMA32(a, b, c) __builtin_amdgcn_mfma_f32_32x32x16_bf16((a), (b), (c), 0, 0, 0)
#define MFMA16(a, b, c) __builtin_amdgcn_mfma_f32_16x16x32_bf16((a), (b), (c), 0, 0, 0)
__device__ __forceinline__ bf16x8 pack8(float a0, float a1, float a2, float a3, float a4, float a5, float a6, float a7) {
    v4u w; w.x = cvt_pk_bf16(a0, a1); w.y = cvt_pk_bf16(a2, a3); w.z = cvt_pk_bf16(a4, a5); w.w = cvt_pk_bf16(a6, a7); return __builtin_bit_cast(bf16x8, w);
}
__device__ __forceinline__ bf16x8 cat44(s16x4 lo, s16x4 hi) { return (bf16x8){lo[0], lo[1], lo[2], lo[3], hi[0], hi[1], hi[2], hi[3]}; }

__device__ __forceinline__ float max3f(float a, float b, float c) { return fmaxf(fmaxf(a, b), c); }
__device__ __forceinline__ void glds16(const void* gsrc, unsigned lds_dst) { unsigned keep;
    asm volatile("s_mov_b32 %0, m0\n\ts_mov_b32 m0, %2\n\ts_nop 0\n\tglobal_load_lds_dwordx4 %1, off\n\ts_mov_b32 m0, %0" : "=&s"(keep) : "v"(gsrc), "s"(lds_dst) : "memory"); }
__device__ __forceinline__ void diff_unit(LAS unsigned char* lds, const bf16* __restrict__ QB, bf16* __restrict__ YB, float* __restrict__ stash, int b, int h, int qb, float lam, float post, const float* __restrict__ subg) {
    constexpr float THR = 8.0f;
    const int tid = pg8::opq_tid(), lane = tid & 63, wid = __builtin_amdgcn_readfirstlane(tid >> 6), r32 = lane & 31, hi = lane >> 5;
    const size_t rowq = (size_t)b * SEQ + qb * 256 + wid * 32 + r32;
    LAS unsigned char* Kb = lds; LAS unsigned char* Vb = lds + 16384;
    const int kkey = 8 * wid + (lane >> 3), kc = (lane & 7) ^ (kkey & 7);
    size_t voff[2];
#pragma unroll
    for (int j = 0; j < 2; ++j) { const int vk = 4 * (2 * wid + j) + (lane >> 4), vc = (lane & 15) ^ ((vk & 3) << 2); voff[j] = ((size_t)b * SEQ + vk) * 1536 + 1024 + h * 128 + vc * 8; }
    const int dvhalf = (lane >> 4) & 1, i16 = lane & 15, q_ = i16 >> 2, p_ = i16 & 3;
    const unsigned vrd = (4 * hi + q_) * 256 + 32 * dvhalf + 8 * p_;
    const unsigned krd = r32 * 128;
    f32x4* st = (f32x4*)(stash + ((size_t)wid * 64 + lane) * 64);
    const unsigned kdst0 = (unsigned)(uintptr_t)Kb + wid * 1024, vdst0 = (unsigned)(uintptr_t)Vb + (2 * wid) * 1024;
#define DF_STAGE_K(t_, buf_) glds16(ksrc + (size_t)(t_) * 64 * 1536, (unsigned)__builtin_amdgcn_readfirstlane(kdst0 + (buf_) * 8192))
#define DF_STAGE_V(t_, buf_) do { const size_t adv_ = (size_t)(t_) * 64 * 1536; \
        glds16(QB + voff[0] + adv_, (unsigned)__builtin_amdgcn_readfirstlane(vdst0 + (buf_) * 16384)); \
        glds16(QB + voff[1] + adv_, (unsigned)__builtin_amdgcn_readfirstlane(vdst0 + (buf_) * 16384 + 1024)); } while (0)
#define DF_QKT(P0, P1, kb_) do { const LAS unsigned char* Kc_ = Kb + (kb_) * 8192; P0 = (f32x16){}; P1 = (f32x16){}; \
        _Pragma("unroll") for (int ks = 0; ks < 4; ++ks) { const unsigned o_ = krd + (((2 * ks + hi) ^ (r32 & 7)) << 4); \
            const bf16x8 a0_ = *(const LAS bf16x8*)(Kc_ + o_), a1_ = *(const LAS bf16x8*)(Kc_ + 4096 + o_); \
            P0 = MFMA32(a0_, qf[ks], P0); P1 = MFMA32(a1_, qf[ks], P1); } } while (0)
#define DF_DECIDE(mx_, first_) do { const float mxl_ = (mx_) - m_run; \
        if ((first_) || __any(mxl_ > THR)) { const float rm_ = fmaxf(mxl_, __shfl_xor(mxl_, 32)); \
            const float dl_ = (first_) ? rm_ : fmaxf(rm_, 0.f), f_ = (first_) ? 1.0f : __builtin_amdgcn_exp2f(-dl_); \
            m_run += dl_; l_run *= f_; \
            _Pragma("unroll") for (int k = 0; k < 4; ++k) O[k] = O[k] * f_; } } while (0)
#define DF_SB __builtin_amdgcn_sched_barrier(0)
#define DF_VR(i_) do { const unsigned o_ = vrd + ((i_) >> 2) * 4096 + ((((i_) & 3) ^ q_) << 6); vl[(i_) & 3] = vtr(Vc_ + o_); vh[(i_) & 3] = vtr(Vc_ + o_ + 2048); } while (0)
#define DF_EX(X, r_) do { X[r_] = __builtin_amdgcn_exp2f(X[r_] - m_run); ls_ += X[r_]; } while (0)
#define DF_STEP(C0, C1, N0, N1, t_, HAS_K2, HAS_N) do { const int t = (t_); \
        if (HAS_K2) DF_STAGE_K(t + 2, t & 1); \
        if (HAS_N) DF_STAGE_V(t + 1, (t + 1) & 1); \
        const LAS unsigned char* Kc_ = Kb + ((t + 1) & 1) * 8192; const LAS unsigned char* Vc_ = Vb + (t & 1) * 16384; \
        bf16x8 ka_[8]; s16x4 vl[4], vh[4]; float ls_ = 0.f; \
        if (HAS_N) { _Pragma("unroll") for (int ks = 0; ks < 4; ++ks) { const unsigned o_ = krd + (((2 * ks + hi) ^ (r32 & 7)) << 4); ka_[2 * ks] = *(const LAS bf16x8*)(Kc_ + o_); ka_[2 * ks + 1] = *(const LAS bf16x8*)(Kc_ + 4096 + o_); } } \
        DF_VR(0); DF_VR(1); DF_SB; \
        _Pragma("unroll") for (int ks = 0; ks < 4; ++ks) { \
            if (HAS_N) { if (ks == 0) { N0 = MFMA32(ka_[0], qf[0], (f32x16){}); N1 = MFMA32(ka_[1], qf[0], (f32x16){}); } else { N0 = MFMA32(ka_[2 * ks], qf[ks], N0); N1 = MFMA32(ka_[2 * ks + 1], qf[ks], N1); } } \
            DF_EX(C0, 4 * ks); DF_EX(C0, 4 * ks + 1); DF_EX(C0, 4 * ks + 2); DF_EX(C0, 4 * ks + 3); DF_SB; } \
        bf16x8 pb[4]; \
        pb[0] = pack8(C0[0], C0[1], C0[2], C0[3], C0[4], C0[5], C0[6], C0[7]); pb[1] = pack8(C0[8], C0[9], C0[10], C0[11], C0[12], C0[13], C0[14], C0[15]); DF_SB; \
        _Pragma("unroll") for (int i = 0; i < 8; ++i) { DF_VR(i + 2); O[i & 3] = MFMA32(cat44(vl[i & 3], vh[i & 3]), pb[i >> 2], O[i & 3]); DF_EX(C1, 2 * i); DF_EX(C1, 2 * i + 1); DF_SB; } \
        pb[2] = pack8(C1[0], C1[1], C1[2], C1[3], C1[4], C1[5], C1[6], C1[7]); pb[3] = pack8(C1[8], C1[9], C1[10], C1[11], C1[12], C1[13], C1[14], C1[15]); DF_SB; \
        float ma_ = -3.0e38f, mb_ = -3.0e38f; \
        _Pragma("unroll") for (int i = 8; i < 16; ++i) { if (i + 2 < 16) DF_VR(i + 2); O[i & 3] = MFMA32(cat44(vl[i & 3], vh[i & 3]), pb[i >> 2], O[i & 3]); \
            if (HAS_N) { ma_ = max3f(ma_, N0[2 * (i - 8)], N0[2 * (i - 8) + 1]); mb_ = max3f(mb_, N1[2 * (i - 8)], N1[2 * (i - 8) + 1]); } DF_SB; } \
        l_run += ls_; \
        if (HAS_N) DF_DECIDE(fmaxf(ma_, mb_), false); \
        VM_WAIT(); __syncthreads(); } while (0)
#pragma unroll 1
    for (int c = 0; c < 2; ++c) {
        const int i = 2 * h + c;
        bf16x8 qf[4];
#pragma unroll
        for (int ks = 0; ks < 4; ++ks) qf[ks] = *(const bf16x8*)(QB + rowq * 1536 + i * 64 + ks * 16 + hi * 8);
        f32x16 O[4];
#pragma unroll
        for (int k = 0; k < 4; ++k) O[k] = (f32x16){};
        float m_run = 0.f, l_run = 0.f;
        const bf16* ksrc = QB + ((size_t)b * SEQ + kkey) * 1536 + 512 + i * 64 + kc * 8;
        __syncthreads();
        DF_STAGE_K(0, 0); DF_STAGE_V(0, 0); DF_STAGE_K(1, 1);
        VM_WAIT(); __syncthreads();
        f32x16 pA0, pA1, pB0, pB1;
        DF_QKT(pA0, pA1, 0);
        { float ma_ = max3f(pA0[0], pA0[1], pA1[0]), mb_ = max3f(pA0[2], pA0[3], pA1[1]); ma_ = max3f(ma_, pA1[2], pA1[3]);
#pragma unroll
          for (int r = 4; r < 16; r += 4) { ma_ = max3f(ma_, pA0[r], pA0[r + 1]); mb_ = max3f(mb_, pA0[r + 2], pA0[r + 3]); ma_ = max3f(ma_, pA1[r], pA1[r + 1]); mb_ = max3f(mb_, pA1[r + 2], pA1[r + 3]); }
          DF_DECIDE(fmaxf(ma_, mb_), true); }
        __syncthreads();
#pragma unroll 1
        for (int t2 = 0; t2 < 62; t2 += 2) {
            DF_STEP(pA0, pA1, pB0, pB1, t2, true, true);
            DF_STEP(pB0, pB1, pA0, pA1, t2 + 1, true, true);
        }
        DF_STEP(pA0, pA1, pB0, pB1, 62, false, true);
        DF_STEP(pB0, pB1, pA0, pA1, 63, false, false);
        const float inv = 1.0f / (l_run + __shfl_xor(l_run, 32));
        if (c == 0) {
#pragma unroll
            for (int k = 0; k < 4; ++k)
#pragma unroll
                for (int r4 = 0; r4 < 4; ++r4) st[k * 4 + r4] = (f32x4){O[k][4 * r4] * inv, O[k][4 * r4 + 1] * inv, O[k][4 * r4 + 2] * inv, O[k][4 * r4 + 3] * inv};
        } else {
            float ss = 0.f;
#pragma unroll
            for (int k = 0; k < 4; ++k)
#pragma unroll
                for (int r4 = 0; r4 < 4; ++r4) { const f32x4 o0 = st[k * 4 + r4];
#pragma unroll
                    for (int j = 0; j < 4; ++j) { const float d = o0[j] - lam * (O[k][4 * r4 + j] * inv); O[k][4 * r4 + j] = d; ss += d * d; } }
            ss += __shfl_xor(ss, 32);
            const float rn = post / sqrtf(ss * (1.0f / 128.0f) + 1e-5f);
            bf16* yp = YB + rowq * 512 + h * 128;
#pragma unroll
            for (int k = 0; k < 4; ++k)
#pragma unroll
                for (int r4 = 0; r4 < 4; ++r4) { const int dv = k * 32 + 8 * r4 + 4 * hi; const f32x4 g = *(const f32x4*)(subg + dv);
                    v2u w; w.x = cvt_pk_bf16(O[k][4 * r4] * rn * g.x, O[k][4 * r4 + 1] * rn * g.y); w.y = cvt_pk_bf16(O[k][4 * r4 + 2] * rn * g.z, O[k][4 * r4 + 3] * rn * g.w);
                    *(v2u*)(yp + dv) = w; }
        }
    }
#undef DF_STAGE_K
#undef DF_STAGE_V
#undef DF_QKT
#undef DF_DECIDE
#undef DF_STEP
#undef DF_SB
#undef DF_VR
#undef DF_EX
}

template <int NKT, class KeyTok, class Bias>
__device__ __forceinline__ void win_tile(LAS unsigned char* vbuf, const bf16* __restrict__ X, int pitch, size_t tq, int qcol, int kcol, int vcol, const KeyTok& keytok, const Bias& biasf,
                                         f32x4 (&O)[4], float& m_out, float& l_out, int lane) {
    const int qi = lane & 15, g = lane >> 4, q_ = qi >> 2, p_ = qi & 3;
    bf16x8 qf[2];
#pragma unroll
    for (int ks = 0; ks < 2; ++ks) qf[ks] = *(const bf16x8*)(X + tq * pitch + qcol + 32 * ks + 8 * g);
    f32x4 s[NKT];
#pragma unroll
    for (int kt = 0; kt < NKT; ++kt) {
        const size_t tk = keytok(kt * 16 + qi);
        const bf16x8 k0 = *(const bf16x8*)(X + tk * pitch + kcol + 8 * g), k1 = *(const bf16x8*)(X + tk * pitch + kcol + 32 + 8 * g);
        f32x4 a = (f32x4){0.f, 0.f, 0.f, 0.f}; a = MFMA16(k0, qf[0], a); a = MFMA16(k1, qf[1], a);
#pragma unroll
        for (int r = 0; r < 4; ++r) s[kt][r] = biasf(kt, 4 * g + r, a[r]);
    }
    v4u vv[4];
#define WT_VLOAD(st_) do { _Pragma("unroll") for (int j = 0; j < 4; ++j) { const int idx = lane + 64 * j, key = idx >> 3, ch = idx & 7; const size_t tv = keytok((st_) * 32 + key); vv[j] = *(const v4u*)(X + tv * pitch + vcol + ch * 8); } } while (0)
    WT_VLOAD(0);
    float mx = -1.0e30f;
#pragma unroll
    for (int kt = 0; kt < NKT; ++kt)
#pragma unroll
        for (int r = 0; r < 4; ++r) mx = fmaxf(mx, s[kt][r]);
    mx = fmaxf(mx, __shfl_xor(mx, 16)); mx = fmaxf(mx, __shfl_xor(mx, 32));
    float l = 0.f;
#pragma unroll
    for (int kt = 0; kt < NKT; ++kt)
#pragma unroll
        for (int r = 0; r < 4; ++r) { s[kt][r] = __builtin_amdgcn_exp2f(s[kt][r] - mx); l += s[kt][r]; }
    l += __shfl_xor(l, 16); l += __shfl_xor(l, 32);
    m_out = mx; l_out = l;
#pragma unroll
    for (int dt = 0; dt < 4; ++dt) O[dt] = (f32x4){0.f, 0.f, 0.f, 0.f};
    const int k0r = 4 * g + q_, k1r = 16 + 4 * g + q_;
    const unsigned rd0 = k0r * 128 + ((8 * p_) ^ (((k0r >> 1) & 3) << 5)), rd1 = k1r * 128 + ((8 * p_) ^ (((k1r >> 1) & 3) << 5));
#pragma unroll
    for (int st = 0; st < NKT / 2; ++st) {
        LAS unsigned char* vb = vbuf + (st & 1) * 4096;
#pragma unroll
        for (int j = 0; j < 4; ++j) { const int idx = lane + 64 * j, key = idx >> 3, ch = idx & 7; *(LAS v4u*)(vb + key * 128 + ((ch * 16) ^ (((key >> 1) & 3) << 5))) = vv[j]; }
        asm volatile("" ::: "memory");
        if (st + 1 < NKT / 2) WT_VLOAD(st + 1);
        LDS_WAIT();
        const bf16x8 pb = pack8(s[2 * st][0], s[2 * st][1], s[2 * st][2], s[2 * st][3], s[2 * st + 1][0], s[2 * st + 1][1], s[2 * st + 1][2], s[2 * st + 1][3]);
#pragma unroll
        for (int dt = 0; dt < 4; ++dt) { const s16x4 lo = vtr(vb + (rd0 ^ (dt << 5))), hh = vtr(vb + (rd1 ^ (dt << 5))); O[dt] = MFMA16(cat44(lo, hh), pb, O[dt]); }
    }
    LDS_WAIT();
#undef WT_VLOAD
}

#ifndef FILL_MASK
#define FILL_MASK 7
#endif
#ifndef REP_G3
#define REP_G3 1
#endif
#ifndef REP_BAR
#define REP_BAR 1
#endif
#ifndef REP_N2
#define REP_N2 1
#endif
#ifndef REP_NR
#define REP_NR 1
#endif
#ifndef REP_G2
#define REP_G2 1
#endif
#ifndef REP_M2
#define REP_M2 1
#endif
#ifndef REP_CONV
#define REP_CONV 1
#endif
#ifndef REP_DIFF
#define REP_DIFF 1
#endif
#ifndef REP_G1
#define REP_G1 1
#endif
#ifndef REP_M1
#define REP_M1 1
#endif
#ifndef REP_NA
#define REP_NA 1
#endif
#ifndef REP_DIL
#define REP_DIL 1
#endif
#ifndef ATTMASK
#define ATTMASK 7
#endif
__device__ __forceinline__ unsigned long long opq64(unsigned long long v) { unsigned lo = __builtin_amdgcn_readfirstlane((unsigned)v), hi = __builtin_amdgcn_readfirstlane((unsigned)(v >> 32)); asm volatile("" : "+s"(lo), "+s"(hi)); return ((unsigned long long)hi << 32) | lo; }
template <class T> __device__ __forceinline__ T* opq(T* p) { return (T*)opq64((unsigned long long)p); }
struct NaKey { size_t base; int cs; __device__ __forceinline__ size_t operator()(int kk) const { return base + (size_t)((kk >> 5) * 64 + cs + (kk & 31)); } };
struct NaBias { const LAS float* tab; int cs, qc, c0, drb;
    __device__ __forceinline__ float operator()(int kt, int kin, float a) const {
        const int kc = cs + (kt & 1) * 16 + kin, dr = drb + (kt >> 1), dc = kc - qc + 15; const bool ok = (kc >= c0) && (kc < c0 + 16);
        const int dcc = dc < 0 ? 0 : (dc > 30 ? 30 : dc); return ok ? a + tab[dr * 31 + dcc] : -1.0e30f; } };
struct DilKey { size_t base; int l0, dil, L; __device__ __forceinline__ size_t operator()(int kk) const { int lk = l0 - 64 + kk; lk = lk < 0 ? 0 : (lk > L - 1 ? L - 1 : lk); return base + (size_t)lk * dil; } };
struct DilBias { int l0, L, lq;
    __device__ __forceinline__ float operator()(int kt, int kin, float a) const { const int lk = l0 - 64 + kt * 16 + kin, d = lk - lq; const bool ok = (lk >= 0) && (lk < L) && (d <= 64) && (d >= -64); return ok ? a : -1.0e30f; } };

__device__ __forceinline__ void att_phase(Frame& F, int l) {
    const int lane = F.lane, wave = F.wave, qi = lane & 15, g = lane >> 4;
    const float lam_init = (l == 0) ? 0.2f : (l == 1) ? 0.35550906759096934f : (l == 2) ? 0.4707130183435842f : 0.5560582041556406f;
    const float d1 = wave_sum(INP(3)[l * 64 + lane] * INP(4)[l * 64 + lane]), d2 = wave_sum(INP(5)[l * 64 + lane] * INP(6)[l * 64 + lane]);
    const float lam = __builtin_amdgcn_exp2f(d1 * LOG2E) - __builtin_amdgcn_exp2f(d2 * LOG2E) + lam_init;
    LAS float* btab = (LAS float*)(F.lds + 114688);
    const float* rpb = INP(2) + (size_t)l * 3720;
    for (int i = F.tid; i < 3720; i += 512) btab[i] = rpb[i] * LOG2E;
    __syncthreads();
    const bf16* QA = WSP(bf16, WS_QA); const bf16* QB = WSP(bf16, WS_QB); const bf16* QC = WSP(bf16, WS_QC);
    for (int rep_ = 0; rep_ < REP_DIFF; ++rep_) if (ATTMASK & 1) { const int u = F.vcu; diff_unit(F.lds, QB, WSP(bf16, WS_YB), WSP(float, WS_STASH) + (size_t)F.bx * 32768, u >> 6, (u >> 4) & 3, u & 15, lam, 1.0f - lam_init, INP(7) + l * 128); }
    LAS unsigned char* vbuf = F.lds + 49152 + wave * 8192;
    bf16* YA = WSP(bf16, WS_YA);
#pragma unroll 1
    for (int it = 0; it < ((ATTMASK & 2) ? 4 * REP_NA : 0); ++it) {
        const int U = F.vcu * 4 + (it & 3), b = U >> 8, h = (U >> 5) & 7, r = 2 * (U & 31) + (wave >> 2), cb = wave & 3;
        const int r0 = (r - 4) < 0 ? 0 : ((r - 4) > 56 ? 56 : (r - 4));
        const int cs = (cb == 0) ? 0 : (cb == 1) ? 8 : (cb == 2) ? 24 : 32;
        const int qc = cb * 16 + qi, c0 = (qc - 8) < 0 ? 0 : ((qc - 8) > 48 ? 48 : (qc - 8));
        const size_t tq = (size_t)b * SEQ + r * 64 + qc;
        NaKey kf{(size_t)b * SEQ + (size_t)r0 * 64, cs}; NaBias bf{btab + h * 465, cs, qc, c0, r0 - r + 7};
        f32x4 O[4]; float mx, ls;
        win_tile<16>(vbuf, QA, 1536, tq, h * 64, 512 + h * 64, 1024 + h * 64, kf, bf, O, mx, ls, lane);
        const float inv = 1.0f / ls;
#pragma unroll
        for (int dt = 0; dt < 4; ++dt) { v2u w; w.x = cvt_pk_bf16(O[dt][0] * inv, O[dt][1] * inv); w.y = cvt_pk_bf16(O[dt][2] * inv, O[dt][3] * inv);
            *(v2u*)(YA + tq * 512 + h * 64 + 16 * dt + 4 * g) = w; }
    }
    bf16* OC = WSP(bf16, WS_OC); float* LSE = WSP(float, WS_LSE);
    const int ub = F.vcu >> 6, uj = (F.vcu >> 4) & 3, usp = F.vcu & 15;
#pragma unroll 1
    for (int it6 = 0; it6 < ((ATTMASK & 4) ? 6 * REP_DIL : 0); ++it6) { const int it = it6 % 6;
        const int tl = wave * 6 + it, gi = tl >> 4, w = tl & 15;
        const int dil = (gi == 0) ? 1 : (gi == 1) ? 4 : 16, L = SEQ / dil;
        const int p = (gi == 0) ? 0 : (gi == 1) ? (w >> 2) : w;
        const int l0 = (gi == 0) ? (usp * 256 + 16 * w) : (gi == 1) ? (usp * 64 + 16 * (w & 3)) : (usp * 16);
        const int hc = gi * 4 + uj;
        const size_t tq = (size_t)ub * SEQ + (size_t)(l0 + qi) * dil + p;
        DilKey kf{(size_t)ub * SEQ + p, l0, dil, L}; DilBias bf{l0, L, l0 + qi};
        f32x4 O[4]; float mx, ls;
        win_tile<10>(vbuf, QC, 2304, tq, hc * 64, 768 + hc * 64, 1536 + hc * 64, kf, bf, O, mx, ls, lane);
        const float inv = 1.0f / ls;
#pragma unroll
        for (int dt = 0; dt < 4; ++dt) { v2u w2; w2.x = cvt_pk_bf16(O[dt][0] * inv, O[dt][1] * inv); w2.y = cvt_pk_bf16(O[dt][2] * inv, O[dt][3] * inv);
            *(v2u*)(OC + tq * 768 + hc * 64 + 16 * dt + 4 * g) = w2; }
        if (g == 0) LSE[tq * 12 + hc] = mx + __builtin_amdgcn_logf(ls);
    }
    VM_WAIT(); __syncthreads();
    bf16* YC = WSP(bf16, WS_YC);
    for (int idx = F.tid; idx < 2048; idx += 512) {
        const size_t tok = (size_t)ub * SEQ + usp * 256 + (idx >> 3); const int ch = idx & 7;
        const float e0 = LSE[tok * 12 + uj], e1 = LSE[tok * 12 + 4 + uj], e2 = LSE[tok * 12 + 8 + uj], em = fmaxf(e0, fmaxf(e1, e2));
        float w0 = __builtin_amdgcn_exp2f(e0 - em), w1 = __builtin_amdgcn_exp2f(e1 - em), w2 = __builtin_amdgcn_exp2f(e2 - em); const float di = 1.0f / (w0 + w1 + w2); w0 *= di; w1 *= di; w2 *= di;
        const v4u a = *(const v4u*)(OC + tok * 768 + uj * 64 + ch * 8), bq = *(const v4u*)(OC + tok * 768 + (4 + uj) * 64 + ch * 8), cq = *(const v4u*)(OC + tok * 768 + (8 + uj) * 64 + ch * 8);
        v4u o;
#pragma unroll
        for (int k = 0; k < 4; ++k) { const float lo = w0 * pg8::bf_lo(a[k]) + w1 * pg8::bf_lo(bq[k]) + w2 * pg8::bf_lo(cq[k]), hi = w0 * pg8::bf_hi(a[k]) + w1 * pg8::bf_hi(bq[k]) + w2 * pg8::bf_hi(cq[k]); o[k] = cvt_pk_bf16(lo, hi); }
        *(v4u*)(YC + tok * 256 + uj * 64 + ch * 8) = o;
    }
}

#ifndef PHMASK
#define PHMASK 0xFFFF
#endif
struct Args { const float* in[22]; float* out; unsigned char* ws; int ph_lo, ph_hi; };
__global__ void __launch_bounds__(NWAVES * 64, 2) hybrid_fwd(Args args) {
    extern __shared__ __attribute__((aligned(16))) unsigned char lds[];
    Frame F;
    F.lds = (LAS unsigned char*)lds; F.MISC = (volatile LAS unsigned*)(F.lds + MISC_OFF);
    F.tid = threadIdx.x; F.lane = F.tid & 63; F.wave = __builtin_amdgcn_readfirstlane(F.tid >> 6);
    F.G = gridDim.x; F.bx = blockIdx.x; F.vcu = (F.bx % 8) * (F.G / 8) + F.bx / 8;
    F.ka = (const CAS unsigned char*)__builtin_amdgcn_kernarg_segment_ptr();
    F.out = args.out; F.ws = args.ws; F.ctl = (unsigned*)(args.ws + WS_CTL);
#define PHASE_BEGIN() do { F.ka = (const CAS unsigned char*)opq64((unsigned long long)__builtin_amdgcn_kernarg_segment_ptr()); \
        F.tid = pg8::opq_tid(); F.lane = F.tid & 63; F.wave = __builtin_amdgcn_readfirstlane(F.tid >> 6); \
        { int bx_ = blockIdx.x; asm volatile("" : "+s"(bx_)); F.bx = bx_; F.vcu = (bx_ % 8) * (F.G / 8) + bx_ / 8; } \
        F.out = *(float* const CAS*)(F.ka + 176); F.ws = *(unsigned char* const CAS*)(F.ka + 184); F.ctl = (unsigned*)(F.ws + WS_CTL); } while (0)
    for (int u = F.tid; u < (LDS_BYTES - LDSCTL_OFF) / 4; u += NWAVES * 64) ((LAS unsigned*)(F.lds + LDSCTL_OFF))[u] = 0u;
    __syncthreads();
    const int lo = args.ph_lo, hi = args.ph_hi;
    XcdBarrier bar; bar.bar = F.ctl + CW_BAR; bar.x = 0; bar.st = F.MISC + 8;
    if (hi - lo > 1) bar = xcd_barrier_post(F.ctl + CW_BAR, F.MISC + 8);
#define IN(k) (lo <= (k) && (k) < hi)
#define SEAM(k) do { if (IN(k) && IN((k) + 1)) { for (int rb_ = 0; rb_ < REP_BAR; ++rb_) xcd_barrier(bar); } } while (0)
    if (IN(0) && (PHMASK & 1)) { PHASE_BEGIN(); rope_tables(F); router_tables(F); conv_layer(F, 0); norm_rows(F, INP(0), F.out, WSP(float, WS_RS1), nullptr); }
    SEAM(0);
#pragma unroll 1
    for (int l = 0; l < DEPTH; ++l) {
        const int pb = 1 + 8 * l;
        if (IN(pb) && (PHMASK & 2)) {
            PHASE_BEGIN(); bf16* ABF = WSP(bf16, WS_ABF);
            pg8::Gemm g{opq(ABF), opq(WSW(WS_WIN, l)), NTOK, INW, DM}; pg8::StaticOrder S; S.init(NTOK, INW, F.G, F.bx);
            pg8::EpiProj E{WSP(bf16, WS_QA), WSP(bf16, WS_QB), WSP(bf16, WS_QC), WSP(bf16, WS_GATE), WSP(float, WS_RS1), WSP(float, WS_ROPEC), WSP(float, WS_ROPES)};
            for (int rep_ = 0; rep_ < REP_G1; ++rep_) pg8::gemm_phase<pg8::EpiProj, pg8::StaticOrder, true, true>(F.lds, g, S, E);
            if (l + 1 < DEPTH && (FILL_MASK & 1)) { phase_done(F, pb); conv_fill(F, l + 1, F.ctl + CW_DONE + 64 * pb); }
        }
        SEAM(pb);
        if (IN(pb + 1) && (PHMASK & 4)) { PHASE_BEGIN(); att_phase(F, l); }
        SEAM(pb + 1);
        if (IN(pb + 2) && (PHMASK & 8)) {
            PHASE_BEGIN();
            for (int rep_ = 0; rep_ < REP_G2; ++rep_) {
            { pg8::Gemm g{opq(WSP(bf16, WS_YA)), opq(WSW(WS_WPA, l)), NTOK, DM, 512}; pg8::StaticOrder S; S.init(NTOK, DM, F.G, F.bx);
              pg8::EpiGate<true> E{WSP(bf16, WS_MERGED), WSP(bf16, WS_GATE), 0}; pg8::gemm_phase<pg8::EpiGate<true>, pg8::StaticOrder, true, true>(F.lds, g, S, E); }
            VM_WAIT(); __syncthreads();
            { pg8::Gemm g{opq(WSP(bf16, WS_YB)), opq(WSW(WS_WPB, l)), NTOK, DM, 512}; pg8::StaticOrder S; S.init(NTOK, DM, F.G, F.bx);
              pg8::EpiGate<false> E{WSP(bf16, WS_MERGED), WSP(bf16, WS_GATE), 1024}; pg8::gemm_phase<pg8::EpiGate<false>, pg8::StaticOrder, true, true>(F.lds, g, S, E); }
            VM_WAIT(); __syncthreads();
            { pg8::Gemm g{opq(WSP(bf16, WS_YC)), opq(WSW(WS_WPC, l)), NTOK, DM, 256}; pg8::StaticOrder S; S.init(NTOK, DM, F.G, F.bx);
              pg8::EpiGate<false> E{WSP(bf16, WS_MERGED), WSP(bf16, WS_GATE), 2048}; pg8::gemm_phase<pg8::EpiGate<false>, pg8::StaticOrder, true, true>(F.lds, g, S, E); }
            VM_WAIT(); __syncthreads(); }
        }
        SEAM(pb + 2);
        if (IN(pb + 3) && (PHMASK & 16)) {
            PHASE_BEGIN();
            pg8::Gemm g{opq(WSP(bf16, WS_MERGED)), opq(WSW(WS_WO, l)), NTOK, DM, DM}; pg8::StaticOrder S; S.init(NTOK, DM, F.G, F.bx);
            if (REP_G3 > 1) { pg8::EpiResid E0{F.out, WSP(float, WS_H1), DM}; pg8::gemm_phase<pg8::EpiResid, pg8::StaticOrder, true, true>(F.lds, g, S, E0); VM_WAIT(); __syncthreads(); }
            pg8::EpiResid E{F.out, F.out, DM}; pg8::gemm_phase<pg8::EpiResid, pg8::StaticOrder, true, true>(F.lds, g, S, E);
        }
        SEAM(pb + 3);
        if (IN(pb + 4) && (PHMASK & 32)) { PHASE_BEGIN(); if (REP_N2 > 1) norm_route(F, l, false); norm_route(F, l, true); }
        SEAM(pb + 4);
        if (IN(pb + 5) && (PHMASK & 64)) {
            PHASE_BEGIN();
            pg8::MoeOrder S; { LAS int* tab = (LAS int*)(F.lds + LDSCTL_OFF); const unsigned* gc = F.ctl + CW_CNT + l * 1024;
                if (F.tid == 0) { int at = 0; for (int j = 0; j < 16; ++j) { const int c = (int)__hip_atomic_load(gc + 64 * j, __ATOMIC_RELAXED, __HIP_MEMORY_SCOPE_AGENT); tab[17 + j] = c; tab[j] = at; at += (c + 255) >> 8; } tab[16] = at; }
                __syncthreads();
                S.tab = tab; S.list = opq(WSP(unsigned, WS_LIST)); S.G = F.G; S.c = F.bx; }
            pg8::Gemm g{opq(WSP(bf16, WS_ABF)), opq(WSW(WS_W13, l)), NTOK, 16384, DM};
            pg8::EpiSwiglu E{WSP(bf16, WS_H1), WSP(float, WS_RS2), S.list}; for (int rep_ = 0; rep_ < REP_M1; ++rep_) pg8::gemm_phase_g<pg8::EpiSwiglu, pg8::MoeOrder>(F.lds, g, S, E);
            if (l + 1 < DEPTH && (FILL_MASK & 2)) { phase_done(F, pb + 5); conv_fill(F, l + 1, F.ctl + CW_DONE + 64 * (pb + 5)); }
        }
        SEAM(pb + 5);
        if (IN(pb + 6) && (PHMASK & 128)) {
            PHASE_BEGIN();
            pg8::MoeOrder S; { LAS int* tab = (LAS int*)(F.lds + LDSCTL_OFF); const unsigned* gc = F.ctl + CW_CNT + l * 1024;
                if (F.tid == 0) { int at = 0; for (int j = 0; j < 16; ++j) { const int c = (int)__hip_atomic_load(gc + 64 * j, __ATOMIC_RELAXED, __HIP_MEMORY_SCOPE_AGENT); tab[17 + j] = c; tab[j] = at; at += (c + 255) >> 8; } tab[16] = at; }
                __syncthreads();
                S.tab = tab; S.list = opq(WSP(unsigned, WS_LIST)); S.G = F.G; S.c = F.bx; }
            pg8::Gemm g{opq(WSP(bf16, WS_H1)), opq(WSW(WS_W2, l)), 36864, 16384, 512};
            pg8::EpiMoeOut E{WSP(bf16, WS_CB), WSP(float, WS_COMB), S.list}; for (int rep_ = 0; rep_ < REP_M2; ++rep_) pg8::gemm_phase<pg8::EpiMoeOut, pg8::MoeOrder, true, true>(F.lds, g, S, E);
            if (l + 1 < DEPTH && (FILL_MASK & 4)) { phase_done(F, pb + 6); conv_fill(F, l + 1, F.ctl + CW_DONE + 64 * (pb + 6)); }
        }
        SEAM(pb + 6);
        if (IN(pb + 7) && (PHMASK & 256)) { PHASE_BEGIN(); if (l + 1 < DEPTH) { conv_rest(F, l + 1); if (REP_NR > 1) norm_rows(F, F.out, WSP(float, WS_QA), WSP(float, WS_RS1), WSP(bf16, WS_CB)); norm_rows(F, F.out, F.out, WSP(float, WS_RS1), WSP(bf16, WS_CB)); } else final_norm(F); }
        if (l + 1 < DEPTH) SEAM(pb + 7);
    }
#undef IN
#undef SEAM
}

extern "C" void kernel_launch(void* const* d_in, const int* in_sizes, int n_in, void* d_out, int out_size, void* d_ws, size_t ws_size, hipStream_t stream) {
    static int grid = 0;
    if (grid == 0) {
        if (n_in != 22 || out_size != NTOK * DM || ws_size < WS_END) { fprintf(stderr, "kernel_launch: unexpected problem (n_in %d, out %d, ws %zu); nothing launched\n", n_in, out_size, ws_size); grid = -1; return; }
        int dev = 0, cus = 0;
        if (hipGetDevice(&dev) != hipSuccess || hipDeviceGetAttribute(&cus, hipDeviceAttributeMultiprocessorCount, dev) != hipSuccess) { grid = -1; return; }
        if (hipFuncSetAttribute((const void*)hybrid_fwd, hipFuncAttributeMaxDynamicSharedMemorySize, LDS_BYTES) != hipSuccess) { fprintf(stderr, "kernel_launch: hipFuncSetAttribute failed\n"); grid = -1; return; }
        int per_cu = 0; (void)hipOccupancyMaxActiveBlocksPerMultiprocessor(&per_cu, (const void*)hybrid_fwd, NWAVES * 64, LDS_BYTES); (void)hipGetLastError();
        grid = (cus == 256) ? 256 : -1;
        if (grid < 0) { fprintf(stderr, "kernel_launch: %d CUs, built for 256; nothing launched\n", cus); return; }
    }
    if (grid < 0) return;
    (void)hipMemsetAsync((char*)d_ws + WS_CTL, 0, CTL_ZERO_BYTES, stream);
    Args a{};
    for (int i = 0; i < 22; ++i) a.in[i] = (const float*)d_in[i];
    a.out = (float*)d_out; a.ws = (unsigned char*)d_ws;
#if MK_ONE_LAUNCH
    a.ph_lo = 0; a.ph_hi = N_PHASES;
    hipLaunchKernelGGL(hybrid_fwd, dim3(grid), dim3(NWAVES * 64), LDS_BYTES, stream, a);
#else
    for (int p = 0; p < N_PHASES; ++p) { a.ph_lo = p; a.ph_hi = p + 1; hipLaunchKernelGGL(hybrid_fwd, dim3(grid), dim3(NWAVES * 64), LDS_BYTES, stream, a); }
#endif
}
```

```cpp
#include <hip/hip_runtime.h>
#include <cstdio>
#include <cstdint>
#define MK_ONE_LAUNCH 1
namespace pg8 {
#define PG8_LAS __attribute__((address_space(3)))
typedef unsigned short bf16_t;
typedef short bf16x8 __attribute__((ext_vector_type(8)));
typedef float f32x4 __attribute__((ext_vector_type(4)));
typedef unsigned u32x4 __attribute__((ext_vector_type(4)));
constexpr int BM = 256, BK = 64, HALF = 128, HTB = HALF * BK * 2  , STAGE_BYTES = 8 * HTB, NXCD = 8, WGM = 8;

__host__ __device__ __forceinline__ int lds_byte(int r, int c) { const int st = (r >> 4) * 2 + (c >> 5), rr = r & 15, cc = c & 31, ob = rr * 64 + cc * 2; return st * 1024 + (ob ^ (((ob >> 9) & 1) << 5)); }
__host__ __device__ __forceinline__ void stage_rc(int b, int& R, int& C) { const int st = b / 1024, sb = b % 1024, swz = sb ^ (((sb >> 9) & 1) << 5); R = (st >> 1) * 16 + swz / 64; C = (st & 1) * 32 + (swz % 64) / 2; }
__host__ __device__ __forceinline__ int perm32(int rho) { const int n = rho >> 4, i = rho & 15; return 8 * (i >> 2) + 4 * n + (i & 3); }

struct Unit { int pm, pn, e, rt, cnt; };
struct Gemm { const bf16_t* A; const bf16_t* Bt; int M, N, K; };

struct StaticOrder {
    int nM, nN, nwg, G, c;
    __host__ __device__ void init(int M, int N, int G_, int c_) { nM = M / BM; nN = N / BM; nwg = nM * nN; G = G_; c = c_; }
    __host__ __device__ bool next(int i, Unit& u) const {
        const long L = (long)i * G + c; if (L >= nwg) return false;
        int wgid = (int)L; { const int q = nwg / NXCD, r = nwg % NXCD, xcd = wgid % NXCD, off = wgid / NXCD; wgid = (xcd < r ? xcd * (q + 1) : r * (q + 1) + (xcd - r) * q) + off; }
        const int nig = WGM * nN, gid = wgid / nig, fm = gid * WGM, gsz = (nM - fm) < WGM ? (nM - fm) : WGM;
        u.pm = fm + ((wgid % nig) % gsz); u.pn = (wgid % nig) / gsz; return true;
    }
    __device__ __forceinline__ void a_ready(const Unit&) const {}
    __device__ __forceinline__ void done(const Unit&) const {}
};
__device__ __forceinline__ unsigned cvt_pk_bf16(float lo, float hi) { unsigned r; asm volatile("v_cvt_pk_bf16_f32 %0, %1, %2" : "=v"(r) : "v"(lo), "v"(hi)); return r; }

__device__ __forceinline__ int opq_tid() { int t = threadIdx.x; asm volatile("" : "+v"(t)); return t; }
template <class Epi, class Sched, bool ALIGN_EPI = false, bool SP2 = false>
__device__ __forceinline__ void gemm_phase(PG8_LAS unsigned char* lds, const Gemm g, const Sched& S, const Epi& E) {
    const int tid = opq_tid(), wid = __builtin_amdgcn_readfirstlane(tid >> 6), lane = tid & 63, wr = wid >> 2, wc = wid & 3, fr = lane & 15, fq = lane >> 4;
    const int K = g.K, nt = K / BK;
    unsigned voffA[2], voffB[2];
#pragma unroll
    for (int i = 0; i < 2; ++i) { int R, C; stage_rc(tid * 16 + i * 8192, R, C); const int Rb = Epi::PERM ? ((R & ~31) + perm32(R & 31)) : R;
        voffA[i] = (unsigned)(R * K + C) * 2u; voffB[i] = (unsigned)(Rb * K + C) * 2u; }
    const size_t kstep = (size_t)(BK * 2);
    const size_t hstep = (size_t)HALF * K * 2;
    const size_t tstep = 2 * hstep;
    const unsigned ldsw = (unsigned)wid * 1024u;
    const int aoff = lds_byte(wr * 64 + fr, fq * 8), boff = lds_byte(wc * 32 + fr, fq * 8);
#define PG8_SA(b, h) (((b) * 2 + (h)) * HTB)
#define PG8_SB(b, h) ((4 + (b) * 2 + (h)) * HTB)
#define PG8_STAGE(bufoff, gbase, voff) do { _Pragma("unroll") for (int _i = 0; _i < 2; ++_i) \
        __builtin_amdgcn_global_load_lds((const unsigned*)((const char*)(gbase) + (voff)[_i]), (PG8_LAS unsigned*)(lds + (bufoff) + ldsw + _i * 8192), 16, 0, 0); } while (0)
#define PG8_LDA(dst, b, h) do { _Pragma("unroll") for (int m = 0; m < 4; ++m) _Pragma("unroll") for (int k = 0; k < 2; ++k) dst[m][k] = *(const PG8_LAS bf16x8*)(lds + PG8_SA(b, h) + aoff + m * 2048 + k * 1024); } while (0)
#define PG8_LDB(dst, b, h) do { _Pragma("unroll") for (int n = 0; n < 2; ++n) _Pragma("unroll") for (int k = 0; k < 2; ++k) dst[n][k] = *(const PG8_LAS bf16x8*)(lds + PG8_SB(b, h) + boff + n * 2048 + k * 1024); } while (0)
#define PG8_MMA(ai, bj, At, Bt) do { __builtin_amdgcn_s_setprio(1); _Pragma("unroll") for (int m = 0; m < 4; ++m) _Pragma("unroll") for (int n = 0; n < 2; ++n) _Pragma("unroll") for (int k = 0; k < 2; ++k) \
        acc[ai][bj][m][n] = __builtin_amdgcn_mfma_f32_16x16x32_bf16(Bt[n][k], At[m][k], acc[ai][bj][m][n], 0, 0, 0); __builtin_amdgcn_s_setprio(0); } while (0)
#define PG8_WAIT_V(n) asm volatile("s_waitcnt vmcnt(" #n ")" ::: "memory")
#define PG8_WAIT_L(n) asm volatile("s_waitcnt lgkmcnt(" #n ")" ::: "memory")
#define PG8_BAR __builtin_amdgcn_s_barrier()
#define PG8_SCHED __builtin_amdgcn_sched_barrier(0)
    Unit cur, nxt; int ui = 0;
    if (!S.next(0, cur)) return;
    f32x4 acc[2][2][4][2];
#pragma unroll
    for (int a = 0; a < 2; ++a)
#pragma unroll
        for (int b = 0; b < 2; ++b)
#pragma unroll
            for (int m = 0; m < 4; ++m)
#pragma unroll
                for (int n = 0; n < 2; ++n) acc[a][b][m][n] = (f32x4){0.f, 0.f, 0.f, 0.f};
    bf16x8 At[4][2], B0[2][2], B1[2][2];
    const char* cA = (const char*)g.A + (size_t)cur.pm * tstep; const char* cB = (const char*)g.Bt + (size_t)cur.pn * tstep;
    S.a_ready(cur);
    if constexpr (SP2) {
        PG8_STAGE(PG8_SB(0, 0), cB, voffB); PG8_STAGE(PG8_SB(0, 1), cB + hstep, voffB); PG8_STAGE(PG8_SA(0, 0), cA, voffA); PG8_STAGE(PG8_SA(0, 1), cA + hstep, voffA);
        if (wr == 1) PG8_BAR;
        PG8_WAIT_V(2); PG8_BAR;
        PG8_STAGE(PG8_SB(1, 0), cB + kstep, voffB); PG8_STAGE(PG8_SA(1, 0), cA + kstep, voffA); PG8_STAGE(PG8_SB(1, 1), cB + hstep + kstep, voffB);
        PG8_WAIT_V(6); PG8_BAR;
    } else {
        PG8_STAGE(PG8_SB(0, 0), cB, voffB); PG8_STAGE(PG8_SA(0, 0), cA, voffA); PG8_STAGE(PG8_SB(0, 1), cB + hstep, voffB); PG8_STAGE(PG8_SA(0, 1), cA + hstep, voffA);
        if (wr == 1) PG8_BAR;
        PG8_WAIT_V(4); PG8_BAR;
        PG8_STAGE(PG8_SB(1, 0), cB + kstep, voffB); PG8_STAGE(PG8_SA(1, 0), cA + kstep, voffA); PG8_STAGE(PG8_SB(1, 1), cB + hstep + kstep, voffB);
        PG8_WAIT_V(6); PG8_BAR;
    }
    for (;;) {
        const bool has_next = S.next(ui + 1, nxt);
        const char* nA = has_next ? (const char*)g.A + (size_t)nxt.pm * tstep : cA; const char* nB = has_next ? (const char*)g.Bt + (size_t)nxt.pn * tstep : cB;
        for (int t = 0; t < nt; t += 2) {
            const bool last = (t == nt - 2);
            const char* a1 = cA + (size_t)(t + 1) * kstep;
            const char* a2 = last ? nA : cA + (size_t)(t + 2) * kstep; const char* b2 = last ? nB : cB + (size_t)(t + 2) * kstep;
            const char* a3 = a2 + kstep; const char* b3 = b2 + kstep;
            if (last && has_next) S.a_ready(nxt);
            if constexpr (SP2) {
            PG8_LDB(B0, 0, 0); PG8_LDB(B1, 0, 1); PG8_SCHED; PG8_LDA(At, 0, 0); PG8_STAGE(PG8_SA(1, 1), a1 + hstep, voffA);
            PG8_WAIT_V(8); PG8_WAIT_L(0); PG8_BAR; PG8_MMA(0, 0, At, B0); PG8_MMA(0, 1, At, B1); PG8_BAR; PG8_SCHED;
            PG8_LDA(At, 0, 1); PG8_STAGE(PG8_SB(0, 0), b2, voffB); PG8_STAGE(PG8_SB(0, 1), b2 + hstep, voffB); PG8_STAGE(PG8_SA(0, 0), a2, voffA);
            PG8_WAIT_V(8); PG8_WAIT_L(0); PG8_BAR; PG8_MMA(1, 0, At, B0); PG8_MMA(1, 1, At, B1); PG8_BAR; PG8_SCHED;
            PG8_LDB(B0, 1, 0); PG8_LDB(B1, 1, 1); PG8_SCHED; PG8_LDA(At, 1, 0); PG8_STAGE(PG8_SA(0, 1), a2 + hstep, voffA);
            PG8_WAIT_V(8); PG8_WAIT_L(0); PG8_BAR; PG8_MMA(0, 0, At, B0); PG8_MMA(0, 1, At, B1); PG8_BAR; PG8_SCHED;
            PG8_LDA(At, 1, 1); PG8_STAGE(PG8_SB(1, 0), b3, voffB); PG8_STAGE(PG8_SB(1, 1), b3 + hstep, voffB); PG8_STAGE(PG8_SA(1, 0), a3, voffA);
            PG8_WAIT_V(8); PG8_WAIT_L(0); PG8_BAR; PG8_MMA(1, 0, At, B0); PG8_MMA(1, 1, At, B1); PG8_BAR; PG8_SCHED;
            } else {
            PG8_LDB(B0, 0, 0); PG8_SCHED; PG8_LDA(At, 0, 0); PG8_STAGE(PG8_SA(1, 1), a1 + hstep, voffA);
            PG8_WAIT_L(8); PG8_BAR; PG8_WAIT_L(0); PG8_MMA(0, 0, At, B0); PG8_BAR; PG8_SCHED;
            PG8_LDB(B1, 0, 1); PG8_STAGE(PG8_SB(0, 0), b2, voffB);
            PG8_BAR; PG8_WAIT_L(0); PG8_MMA(0, 1, At, B1); PG8_BAR;
            PG8_LDA(At, 0, 1); PG8_STAGE(PG8_SA(0, 0), a2, voffA);
            PG8_BAR; PG8_WAIT_L(0); PG8_MMA(1, 0, At, B0); PG8_BAR; PG8_SCHED;
            PG8_STAGE(PG8_SB(0, 1), b2 + hstep, voffB);
            PG8_WAIT_V(6); PG8_BAR; PG8_MMA(1, 1, At, B1); PG8_BAR;
            PG8_LDB(B0, 1, 0); PG8_SCHED; PG8_LDA(At, 1, 0); PG8_STAGE(PG8_SA(0, 1), a2 + hstep, voffA);
            PG8_WAIT_L(8); PG8_BAR; PG8_WAIT_L(0); PG8_MMA(0, 0, At, B0); PG8_BAR; PG8_SCHED;
            PG8_LDB(B1, 1, 1); PG8_STAGE(PG8_SB(1, 0), b3, voffB);
            PG8_BAR; PG8_WAIT_L(0); PG8_MMA(0, 1, At, B1); PG8_BAR;
            PG8_LDA(At, 1, 1); PG8_STAGE(PG8_SA(1, 0), a3, voffA);
            PG8_BAR; PG8_WAIT_L(0); PG8_MMA(1, 0, At, B0); PG8_BAR; PG8_SCHED;
            PG8_STAGE(PG8_SB(1, 1), b3 + hstep, voffB);
            PG8_WAIT_V(6); PG8_BAR; PG8_MMA(1, 1, At, B1); PG8_BAR;
            }
        }
        if constexpr (ALIGN_EPI) { if (wr == 0) PG8_BAR; }
        if constexpr (!Epi::AFTER_DRAIN) { E(acc, cur, wr, wc, fr, fq); S.done(cur); }
        if (!has_next) break;
#pragma unroll
        for (int a = 0; a < 2; ++a)
#pragma unroll
            for (int b = 0; b < 2; ++b)
#pragma unroll
                for (int m = 0; m < 4; ++m)
#pragma unroll
                    for (int n = 0; n < 2; ++n) acc[a][b][m][n] = (f32x4){0.f, 0.f, 0.f, 0.f};
        cur = nxt; cA = nA; cB = nB; ++ui;
        if constexpr (ALIGN_EPI) { if (wr == 1) PG8_BAR; }
    }
    PG8_WAIT_V(0);
    if constexpr (!ALIGN_EPI) { if (wr == 0) PG8_BAR; }
    PG8_BAR;
    if constexpr (Epi::AFTER_DRAIN) { E.fused(acc, cur, wr, wc, fr, fq, lds, wid, lane); S.done(cur); }
#undef PG8_SA
#undef PG8_SB
#undef PG8_STAGE
#undef PG8_LDA
#undef PG8_LDB
#undef PG8_MMA
#undef PG8_WAIT_V
#undef PG8_WAIT_L
#undef PG8_BAR
#undef PG8_SCHED
}
}

namespace pg8 {
typedef unsigned u32x2 __attribute__((ext_vector_type(2)));
constexpr float LOG2E = 1.4426950408889634f;
constexpr float C2 = 0.125f * 1.4426950408889634f;
__device__ __forceinline__ float bf_lo(unsigned w) { return __uint_as_float(w << 16); }
__device__ __forceinline__ float bf_hi(unsigned w) { return __uint_as_float(w & 0xffff0000u); }
__device__ __forceinline__ float sigmoid_f(float x) { return __builtin_amdgcn_rcpf(1.0f + __builtin_amdgcn_exp2f(-x * LOG2E)); }

struct EpiProj {
    static constexpr bool PERM = true, AFTER_DRAIN = false;
    bf16_t *QA, *QB, *QC, *GT; const float* rs; const float* ropec; const float* ropes;
    __device__ __forceinline__ void operator()(const f32x4 (&acc)[2][2][4][2], const Unit& u, int wr, int wc, int fr, int fq) const {
        const int pn = u.pn; bf16_t* base; int ldc, colt, mode; float sc = 1.f;
        if (pn < 6)       { base = QA; ldc = 1536; colt = pn * 256;        mode = 0;                if (pn < 2)  sc = C2; }
        else if (pn < 12) { base = QB; ldc = 1536; colt = (pn - 6) * 256;  mode = (pn < 10) ? 1 : 0; if (pn < 8)  sc = C2; }
        else if (pn < 21) { base = QC; ldc = 2304; colt = (pn - 12) * 256; mode = (pn < 18) ? 1 : 0; if (pn < 15) sc = C2; }
        else              { base = GT; ldc = 3072; colt = (pn - 21) * 256; mode = 2; }
        const int row0 = u.pm * BM + wr * 64 + fr, col0 = colt + wc * 32 + 8 * fq;
        const bool ropew = (mode == 1) && ((wc & 1) == 0);
#pragma unroll
        for (int ai = 0; ai < 2; ++ai)
#pragma unroll
            for (int m = 0; m < 4; ++m) {
                const int row = row0 + ai * HALF + m * 16; const float r = rs[row] * sc;
                f32x4 c0 = {1.f, 1.f, 1.f, 1.f}, c1 = c0, s0 = {0.f, 0.f, 0.f, 0.f}, s1 = s0;
                if (ropew) { const int t = row & 4095; c0 = *(const f32x4*)(ropec + t * 8); c1 = *(const f32x4*)(ropec + t * 8 + 4); s0 = *(const f32x4*)(ropes + t * 8); s1 = *(const f32x4*)(ropes + t * 8 + 4);
                    if (fq == 0) { s0 = -s0; s1 = -s1; } if (fq >= 2) { c0 = (f32x4){1.f, 1.f, 1.f, 1.f}; c1 = c0; s0 = (f32x4){0.f, 0.f, 0.f, 0.f}; s1 = s0; } }
                bf16_t* rowp = base + (size_t)row * ldc + col0;
#pragma unroll
                for (int bj = 0; bj < 2; ++bj) {
                    f32x4 v0 = acc[ai][bj][m][0] * r, v1 = acc[ai][bj][m][1] * r;
                    if (ropew) {
                        f32x4 p0, p1;
#pragma unroll
                        for (int j = 0; j < 4; ++j) { p0[j] = __shfl_xor(v0[j], 16); p1[j] = __shfl_xor(v1[j], 16); }
                        v0 = v0 * c0 + p0 * s0; v1 = v1 * c1 + p1 * s1;
                    }
                    if (mode == 2) {
#pragma unroll
                        for (int j = 0; j < 4; ++j) { v0[j] = sigmoid_f(v0[j]); v1[j] = sigmoid_f(v1[j]); }
                    }
                    u32x4 w; w.x = cvt_pk_bf16(v0[0], v0[1]); w.y = cvt_pk_bf16(v0[2], v0[3]); w.z = cvt_pk_bf16(v1[0], v1[1]); w.w = cvt_pk_bf16(v1[2], v1[3]);
                    *(u32x4*)(rowp + bj * HALF) = w;
                }
            }
    }
};

template <bool FIRST> struct EpiGate {
    static constexpr bool PERM = true, AFTER_DRAIN = false;
    bf16_t* MG; const bf16_t* GT; int gcol;
    __device__ __forceinline__ void operator()(const f32x4 (&acc)[2][2][4][2], const Unit& u, int wr, int wc, int fr, int fq) const {
        const int row0 = u.pm * BM + wr * 64 + fr, col0 = u.pn * BM + wc * 32 + 8 * fq;
#pragma unroll
        for (int ai = 0; ai < 2; ++ai)
#pragma unroll
            for (int m = 0; m < 4; ++m) {
                const int row = row0 + ai * HALF + m * 16;
#pragma unroll
                for (int bj = 0; bj < 2; ++bj) {
                    const int col = col0 + bj * HALF;
                    const u32x4 g = *(const u32x4*)(GT + (size_t)row * 3072 + gcol + col);
                    f32x4 v0 = acc[ai][bj][m][0], v1 = acc[ai][bj][m][1];
                    v0[0] *= bf_lo(g.x); v0[1] *= bf_hi(g.x); v0[2] *= bf_lo(g.y); v0[3] *= bf_hi(g.y);
                    v1[0] *= bf_lo(g.z); v1[1] *= bf_hi(g.z); v1[2] *= bf_lo(g.w); v1[3] *= bf_hi(g.w);
                    bf16_t* op = MG + (size_t)row * 1024 + col;
                    if (!FIRST) { const u32x4 o = *(const u32x4*)op;
                        v0[0] += bf_lo(o.x); v0[1] += bf_hi(o.x); v0[2] += bf_lo(o.y); v0[3] += bf_hi(o.y);
                        v1[0] += bf_lo(o.z); v1[1] += bf_hi(o.z); v1[2] += bf_lo(o.w); v1[3] += bf_hi(o.w); }
                    u32x4 w; w.x = cvt_pk_bf16(v0[0], v0[1]); w.y = cvt_pk_bf16(v0[2], v0[3]); w.z = cvt_pk_bf16(v1[0], v1[1]); w.w = cvt_pk_bf16(v1[2], v1[3]);
                    *(u32x4*)op = w;
                }
            }
    }
};

struct EpiResid {
    static constexpr bool PERM = false, AFTER_DRAIN = false;
    const float* base; float* out; int ldc;
    __device__ __forceinline__ void operator()(const f32x4 (&acc)[2][2][4][2], const Unit& u, int wr, int wc, int fr, int fq) const {
        const int row0 = u.pm * BM + wr * 64 + fr, col0 = u.pn * BM + wc * 32 + 4 * fq;
#pragma unroll
        for (int ai = 0; ai < 2; ++ai)
#pragma unroll
            for (int m = 0; m < 4; ++m) { const size_t off = (size_t)(row0 + ai * HALF + m * 16) * ldc + col0;
#pragma unroll
                for (int bj = 0; bj < 2; ++bj)
#pragma unroll
                    for (int n = 0; n < 2; ++n) { const f32x4 b = *(const f32x4*)(base + off + bj * HALF + n * 16); *(f32x4*)(out + off + bj * HALF + n * 16) = b + acc[ai][bj][m][n]; } }
    }
};

struct MoeOrder {
    const PG8_LAS int* tab; const unsigned* list; int G, c;
    __device__ __forceinline__ bool next(int i, Unit& u) const {
        const int L = i * G + c, tile = L >> 2; if (tile >= __builtin_amdgcn_readfirstlane(tab[16])) return false;
        int e = 0, base = 0;
#pragma unroll
        for (int j = 1; j < 16; ++j) { const int t = tab[j]; if (tile >= t) { e = j; base = t; } }
        e = __builtin_amdgcn_readfirstlane(e); base = __builtin_amdgcn_readfirstlane(base);
        u.pm = tile; u.pn = e * 4 + (L & 3); u.e = e; u.rt = tile - base; u.cnt = __builtin_amdgcn_readfirstlane(tab[17 + e]); return true;
    }
    __device__ __forceinline__ unsigned a_row(const Unit& u, int r) const { const int idx = u.rt * 256 + r; return (idx < u.cnt) ? (list[u.e * 16384 + idx] >> 1) : 0u; }
    __device__ __forceinline__ void a_ready(const Unit&) const {}
    __device__ __forceinline__ void done(const Unit&) const {}
};
struct EpiSwiglu {
    static constexpr bool PERM = false, AFTER_DRAIN = false;
    bf16_t* H1; const float* rs; const unsigned* list;
    __device__ __forceinline__ void operator()(const f32x4 (&acc)[2][2][4][2], const Unit& u, int wr, int wc, int fr, int fq) const {
        const int q = u.pn & 3; const int r0 = wr * 64 + fr, j0 = 128 * q + 16 * wc + 4 * fq;
#pragma unroll
        for (int ai = 0; ai < 2; ++ai)
#pragma unroll
            for (int m = 0; m < 4; ++m) {
                const int rl = r0 + ai * HALF + m * 16, idx = u.rt * 256 + rl; const bool ok = idx < u.cnt;
                const unsigned tok = ok ? (list[u.e * 16384 + idx] >> 1) : 0u; const float r = rs[tok];
#pragma unroll
                for (int bj = 0; bj < 2; ++bj) {
                    const f32x4 a1 = acc[ai][bj][m][0] * r, a3 = acc[ai][bj][m][1] * r; f32x4 hv;
#pragma unroll
                    for (int j = 0; j < 4; ++j) hv[j] = a1[j] * sigmoid_f(a1[j]) * a3[j];
                    u32x2 w; w.x = cvt_pk_bf16(hv[0], hv[1]); w.y = cvt_pk_bf16(hv[2], hv[3]);
                    if (ok) *(u32x2*)(H1 + (size_t)(u.pm * BM + rl) * 512 + j0 + 64 * bj) = w;
                }
            }
    }
};
struct EpiMoeOut {
    static constexpr bool PERM = true, AFTER_DRAIN = false;
    bf16_t* CB; const float* comb; const unsigned* list;
    __device__ __forceinline__ void operator()(const f32x4 (&acc)[2][2][4][2], const Unit& u, int wr, int wc, int fr, int fq) const {
        const int r0 = wr * 64 + fr, col0 = (u.pn & 3) * BM + wc * 32 + 8 * fq;
#pragma unroll
        for (int ai = 0; ai < 2; ++ai)
#pragma unroll
            for (int m = 0; m < 4; ++m) {
                const int rl = r0 + ai * HALF + m * 16, idx = u.rt * 256 + rl; const bool ok = idx < u.cnt;
                const unsigned ent = ok ? list[u.e * 16384 + idx] : 0u; const float cw = comb[(size_t)(ent >> 1) * 16 + u.e];
#pragma unroll
                for (int bj = 0; bj < 2; ++bj) {
                    const f32x4 v0 = acc[ai][bj][m][0] * cw, v1 = acc[ai][bj][m][1] * cw;
                    u32x4 w; w.x = cvt_pk_bf16(v0[0], v0[1]); w.y = cvt_pk_bf16(v0[2], v0[3]); w.z = cvt_pk_bf16(v1[0], v1[1]); w.w = cvt_pk_bf16(v1[2], v1[3]);
                    if (ok) *(u32x4*)(CB + (size_t)ent * 1024 + col0 + bj * HALF) = w;
                }
            }
    }
};
}

namespace pg8 {
template <class Epi, class Sched>
__device__ __forceinline__ void gemm_phase_g(PG8_LAS unsigned char* lds, const Gemm g, const Sched& S, const Epi& E) {
    const int tid = opq_tid(), wid = __builtin_amdgcn_readfirstlane(tid >> 6), lane = tid & 63, wr = wid >> 2, wc = wid & 3, fr = lane & 15, fq = lane >> 4;
    const int K = g.K, nt = K / BK;
    unsigned voffB[2]; int RA[2], CA[2];
#pragma unroll
    for (int i = 0; i < 2; ++i) { int R, C; stage_rc(tid * 16 + i * 8192, R, C); const int Rb = Epi::PERM ? ((R & ~31) + perm32(R & 31)) : R;
        RA[i] = R; CA[i] = C; voffB[i] = (unsigned)(Rb * K + C) * 2u; }
    const size_t kstep = (size_t)(BK * 2);
    const size_t hstep = (size_t)HALF * K * 2;
    const size_t tstep = 2 * hstep;
    const unsigned ldsw = (unsigned)wid * 1024u;
    const int aoff = lds_byte(wr * 64 + fr, fq * 8), boff = lds_byte(wc * 32 + fr, fq * 8);
#define PG8_SA(b, h) (((b) * 2 + (h)) * HTB)
#define PG8_SB(b, h) ((4 + (b) * 2 + (h)) * HTB)
#define PG8_STAGE(bufoff, gbase, voff) do { _Pragma("unroll") for (int _i = 0; _i < 2; ++_i) \
        __builtin_amdgcn_global_load_lds((const unsigned*)((const char*)(gbase) + (voff)[_i]), (PG8_LAS unsigned*)(lds + (bufoff) + ldsw + _i * 8192), 16, 0, 0); } while (0)
#define PG8_LDA(dst, b, h) do { _Pragma("unroll") for (int m = 0; m < 4; ++m) _Pragma("unroll") for (int k = 0; k < 2; ++k) dst[m][k] = *(const PG8_LAS bf16x8*)(lds + PG8_SA(b, h) + aoff + m * 2048 + k * 1024); } while (0)
#define PG8_LDB(dst, b, h) do { _Pragma("unroll") for (int n = 0; n < 2; ++n) _Pragma("unroll") for (int k = 0; k < 2; ++k) dst[n][k] = *(const PG8_LAS bf16x8*)(lds + PG8_SB(b, h) + boff + n * 2048 + k * 1024); } while (0)
#define PG8_MMA(ai, bj, At, Bt) do { __builtin_amdgcn_s_setprio(1); _Pragma("unroll") for (int m = 0; m < 4; ++m) _Pragma("unroll") for (int n = 0; n < 2; ++n) _Pragma("unroll") for (int k = 0; k < 2; ++k) \
        acc[ai][bj][m][n] = __builtin_amdgcn_mfma_f32_16x16x32_bf16(Bt[n][k], At[m][k], acc[ai][bj][m][n], 0, 0, 0); __builtin_amdgcn_s_setprio(0); } while (0)
#define PG8_WAIT_V(n) asm volatile("s_waitcnt vmcnt(" #n ")" ::: "memory")
#define PG8_WAIT_L(n) asm volatile("s_waitcnt lgkmcnt(" #n ")" ::: "memory")
#define PG8_BAR __builtin_amdgcn_s_barrier()
#define PG8_SCHED __builtin_amdgcn_sched_barrier(0)
#define PG8_AOFFS(dst, u) do { _Pragma("unroll") for (int _h = 0; _h < 2; ++_h) _Pragma("unroll") for (int _i = 0; _i < 2; ++_i) \
        dst[_h][_i] = (unsigned)(S.a_row((u), _h * HALF + RA[_i]) * (unsigned)K + (unsigned)CA[_i]) * 2u; } while (0)
    Unit cur, nxt; int ui = 0;
    if (!S.next(0, cur)) return;
    f32x4 acc[2][2][4][2];
#pragma unroll
    for (int a = 0; a < 2; ++a)
#pragma unroll
        for (int b = 0; b < 2; ++b)
#pragma unroll
            for (int m = 0; m < 4; ++m)
#pragma unroll
                for (int n = 0; n < 2; ++n) acc[a][b][m][n] = (f32x4){0.f, 0.f, 0.f, 0.f};
    bf16x8 At[4][2], B0[2][2], B1[2][2];
    unsigned vc[2][2], vn[2][2];
    PG8_AOFFS(vc, cur);
    const char* const gA = (const char*)g.A;
    const char* cB = (const char*)g.Bt + (size_t)cur.pn * tstep;
    S.a_ready(cur);
    PG8_STAGE(PG8_SB(0, 0), cB, voffB); PG8_STAGE(PG8_SB(0, 1), cB + hstep, voffB); PG8_STAGE(PG8_SA(0, 0), gA, vc[0]); PG8_STAGE(PG8_SA(0, 1), gA, vc[1]);
    if (wr == 1) PG8_BAR;
    PG8_WAIT_V(2); PG8_BAR;
    PG8_STAGE(PG8_SB(1, 0), cB + kstep, voffB); PG8_STAGE(PG8_SA(1, 0), gA + kstep, vc[0]); PG8_STAGE(PG8_SB(1, 1), cB + hstep + kstep, voffB);
    PG8_WAIT_V(6); PG8_BAR;
    for (;;) {
        const bool has_next = S.next(ui + 1, nxt);
        if (has_next) { PG8_AOFFS(vn, nxt); } else {
#pragma unroll
            for (int _h = 0; _h < 2; ++_h)
#pragma unroll
                for (int _i = 0; _i < 2; ++_i) vn[_h][_i] = vc[_h][_i]; }
        const char* nB = has_next ? (const char*)g.Bt + (size_t)nxt.pn * tstep : cB;
        for (int t = 0; t < nt; t += 2) {
            const bool last = (t == nt - 2);
            const char* a1 = gA + (size_t)(t + 1) * kstep;
            const char* a2 = last ? gA : gA + (size_t)(t + 2) * kstep; const char* b2 = last ? nB : cB + (size_t)(t + 2) * kstep;
            const char* a3 = a2 + kstep; const char* b3 = b2 + kstep;
            unsigned v2[2][2];
#pragma unroll
            for (int _h = 0; _h < 2; ++_h)
#pragma unroll
                for (int _i = 0; _i < 2; ++_i) v2[_h][_i] = last ? vn[_h][_i] : vc[_h][_i];
            if (last && has_next) S.a_ready(nxt);
            PG8_LDB(B0, 0, 0); PG8_LDB(B1, 0, 1); PG8_SCHED; PG8_LDA(At, 0, 0); PG8_STAGE(PG8_SA(1, 1), a1, vc[1]);
            PG8_WAIT_V(8); PG8_WAIT_L(0); PG8_BAR; PG8_MMA(0, 0, At, B0); PG8_MMA(0, 1, At, B1); PG8_BAR; PG8_SCHED;
            PG8_LDA(At, 0, 1); PG8_STAGE(PG8_SB(0, 0), b2, voffB); PG8_STAGE(PG8_SB(0, 1), b2 + hstep, voffB); PG8_STAGE(PG8_SA(0, 0), a2, v2[0]);
            PG8_WAIT_V(8); PG8_WAIT_L(0); PG8_BAR; PG8_MMA(1, 0, At, B0); PG8_MMA(1, 1, At, B1); PG8_BAR; PG8_SCHED;
            PG8_LDB(B0, 1, 0); PG8_LDB(B1, 1, 1); PG8_SCHED; PG8_LDA(At, 1, 0); PG8_STAGE(PG8_SA(0, 1), a2, v2[1]);
            PG8_WAIT_V(8); PG8_WAIT_L(0); PG8_BAR; PG8_MMA(0, 0, At, B0); PG8_MMA(0, 1, At, B1); PG8_BAR; PG8_SCHED;
            PG8_LDA(At, 1, 1); PG8_STAGE(PG8_SB(1, 0), b3, voffB); PG8_STAGE(PG8_SB(1, 1), b3 + hstep, voffB); PG8_STAGE(PG8_SA(1, 0), a3, v2[0]);
            PG8_WAIT_V(8); PG8_WAIT_L(0); PG8_BAR; PG8_MMA(1, 0, At, B0); PG8_MMA(1, 1, At, B1); PG8_BAR; PG8_SCHED;
        }
        if (wr == 0) PG8_BAR;
        E(acc, cur, wr, wc, fr, fq); S.done(cur);
        if (!has_next) break;
#pragma unroll
        for (int a = 0; a < 2; ++a)
#pragma unroll
            for (int b = 0; b < 2; ++b)
#pragma unroll
                for (int m = 0; m < 4; ++m)
#pragma unroll
                    for (int n = 0; n < 2; ++n) acc[a][b][m][n] = (f32x4){0.f, 0.f, 0.f, 0.f};
        cur = nxt; cB = nB; ++ui;
#pragma unroll
        for (int _h = 0; _h < 2; ++_h)
#pragma unroll
            for (int _i = 0; _i < 2; ++_i) vc[_h][_i] = vn[_h][_i];
        if (wr == 1) PG8_BAR;
    }
    PG8_WAIT_V(0);
    PG8_BAR;
#undef PG8_SA
#undef PG8_SB
#undef PG8_STAGE
#undef PG8_LDA
#undef PG8_LDB
#undef PG8_MMA
#undef PG8_WAIT_V
#undef PG8_WAIT_L
#undef PG8_BAR
#undef PG8_SCHED
#undef PG8_AOFFS
}
}

constexpr int NTOK = 16384, DM = 1024, SEQ = 4096, DEPTH = 4, INW = 8448;
constexpr int NWAVES = 8;
constexpr int N_PHASES = 1 + 8 * DEPTH;
#ifndef MK_ONE_LAUNCH
#define MK_ONE_LAUNCH 0
#endif
constexpr size_t MiB = 1u << 20;
constexpr size_t WS_CTL = 0, CTL_ZERO_BYTES = 1 * MiB;
constexpr size_t WS_RS1 = 1 * MiB, WS_RS2 = WS_RS1 + 65536, WS_ROPEC = WS_RS2 + 65536, WS_ROPES = WS_ROPEC + 131072;
constexpr size_t WS_LSE = 2 * MiB;
constexpr size_t WS_COMB = 3 * MiB;
constexpr size_t WS_WIN = 4 * MiB, WS_WPA = 21 * MiB, WS_WPB = 22 * MiB, WS_WPC = 23 * MiB, WS_WO = 24 * MiB, WS_W13 = 26 * MiB, WS_W2 = 58 * MiB;
constexpr size_t WS_ABF = 74 * MiB;
constexpr size_t WS_QA = 106 * MiB, WS_QB = 154 * MiB, WS_QC = 202 * MiB, WS_GATE = 274 * MiB;
constexpr size_t WS_H1 = 106 * MiB;
constexpr size_t WS_CB = 146 * MiB;
constexpr size_t WS_YA = 370 * MiB, WS_YB = 386 * MiB, WS_YC = 402 * MiB, WS_OC = 410 * MiB, WS_STASH = 434 * MiB, WS_MERGED = 466 * MiB, WS_LIST = 498 * MiB, WS_RT = 499 * MiB  , WS_WSET1 = 500 * MiB  , WS_END = 570 * MiB;
constexpr size_t WSET_STRIDE = WS_WSET1 - 4 * MiB;
static_assert(WS_H1 + (size_t)36864 * 512 * 2 <= WS_CB && WS_CB + (size_t)2 * NTOK * 1024 * 2 <= WS_YA, "MoE overlays");
constexpr int CW_BAR = 4096, CW_CNT = 8192, CW_QHEAD = 12288  , CW_DONE = 12800  ;
constexpr int CONV_ITEMS = 16 * 264 + 2 * 8 * 32 + 4 * 32 + 16 * 32 + 16 * 512 + 16 * 256;
constexpr int RING_BYTES = 131072, LDSCTL_OFF = 147456, MISC_OFF = LDSCTL_OFF + 320, BTAB_OFF = LDSCTL_OFF + 1024, LDS_BYTES = 163840;
static_assert(BTAB_OFF + 3720 * 4 <= LDS_BYTES, "LDS map");

#define GAS __attribute__((address_space(1)))
#define LAS __attribute__((address_space(3)))
typedef unsigned short bf16;
typedef unsigned v4u __attribute__((ext_vector_type(4)));
typedef unsigned v2u __attribute__((ext_vector_type(2)));
typedef float f32x4 __attribute__((ext_vector_type(4)));
typedef float f32x16 __attribute__((ext_vector_type(16)));
typedef short bf16x8 __attribute__((ext_vector_type(8)));
typedef short s16x4 __attribute__((ext_vector_type(4)));
#define LDS_WAIT() asm volatile("s_waitcnt lgkmcnt(0)" ::: "memory")
#define VM_WAIT() asm volatile("s_waitcnt vmcnt(0)" ::: "memory")
using pg8::cvt_pk_bf16;
using pg8::LOG2E;
__device__ __forceinline__ float wave_sum(float v) {
#pragma unroll
    for (int o = 1; o < 64; o <<= 1) v += __shfl_xor(v, o);
    return v;
}
__device__ __forceinline__ s16x4 vtr(const LAS unsigned char* p) { return __builtin_bit_cast(s16x4, __builtin_amdgcn_ds_read_tr16_b64_v4i16((LAS s16x4*)p)); }

#define XB_TMO      128
#define XB_XCNT(j)  (256  + 64 * (j))
#define XB_XSUB(j)  (1280 + 64 * (j))
#define XB_XGEN(j)  (2304 + 64 * (j))
#define XB_TOP      3328
#define XB_TOPGEN   3392
#define XCD_BAR_WORDS 3456
#define XB_SPIN_CAP (1u << 18)

__device__ __forceinline__ unsigned xb_ld(unsigned* p)              { return __hip_atomic_load(p, __ATOMIC_RELAXED, __HIP_MEMORY_SCOPE_AGENT); }
__device__ __forceinline__ unsigned xb_add(unsigned* p, unsigned v) { return __hip_atomic_fetch_add(p, v, __ATOMIC_RELAXED, __HIP_MEMORY_SCOPE_AGENT); }
__device__ __forceinline__ unsigned xb_xcc_id() { return (unsigned)__builtin_amdgcn_s_getreg((3 << 11) | 20) & 0xFu; }
#define XB_SPIN(cond, bar) do { unsigned _sp = 0; while (cond) { __builtin_amdgcn_s_sleep(1); \
    if ((++_sp & 255u) == 0u) { if (xb_ld(&(bar)[XB_TMO])) break; if (_sp > XB_SPIN_CAP) { atomicAdd(&(bar)[XB_TMO], 1u); break; } } } } while (0)

struct XcdBarrier {
    unsigned* bar; unsigned x;
    volatile LAS unsigned* st;
};

__device__ __forceinline__ XcdBarrier xcd_barrier_post(unsigned* bar, volatile LAS unsigned* st) {
    XcdBarrier b; b.bar = bar; b.x = xb_xcc_id(); b.st = st;
    if (threadIdx.x == 0) (void)xb_add(&bar[XB_XCNT(b.x)], 1u);
    return b;
}
__device__ __forceinline__ void xcd_barrier_complete(unsigned* bar, unsigned x, unsigned& nloc, unsigned& nx) {
    const unsigned G = gridDim.x * gridDim.y * gridDim.z;
    unsigned sum, cnt, mine, sp = 0u;
    for (;;) {
        sum = 0u; cnt = 0u; mine = 0u;
#pragma unroll
        for (unsigned j = 0; j < 16; ++j) { const unsigned c = xb_ld(&bar[XB_XCNT(j)]); sum += c; cnt += (c > 0u) ? 1u : 0u; mine = (j == x) ? c : mine; }
        if (sum == G) break;
        __builtin_amdgcn_s_sleep(1);
        if ((++sp & 255u) == 0u) { if (xb_ld(&bar[XB_TMO])) break; if (sp > XB_SPIN_CAP) { atomicAdd(&bar[XB_TMO], 1u); break; } }
    }
    nloc = mine > 0u ? mine : 1u; nx = cnt > 0u ? cnt : 1u;
}

__device__ __forceinline__ void xcd_barrier(const XcdBarrier& b) {
    asm volatile("s_waitcnt vmcnt(0)" ::: "memory");
    __syncthreads();
    if (threadIdx.x == 0) {
        unsigned* bar = b.bar;
        __builtin_amdgcn_s_waitcnt(0);
        unsigned nloc = b.st[0], nx = b.st[1];
        if (nloc == 0u) { xcd_barrier_complete(bar, b.x, nloc, nx); b.st[0] = nloc; b.st[1] = nx; }
        const unsigned old = xb_add(&bar[XB_XSUB(b.x)], 1u);
        const unsigned gen = old / nloc;
        if (old + 1u == (gen + 1u) * nloc) {
            __builtin_amdgcn_fence(__ATOMIC_RELEASE, "agent");
            asm volatile("s_waitcnt vmcnt(0)" ::: "memory");
            const unsigned og = xb_add(&bar[XB_TOP], 1u);
            const unsigned tg = og / nx;
            if (og + 1u == (tg + 1u) * nx) xb_add(&bar[XB_TOPGEN], 1u);
            else XB_SPIN(xb_ld(&bar[XB_TOPGEN]) == tg, bar);
            __builtin_amdgcn_fence(__ATOMIC_ACQUIRE, "agent");
            xb_add(&bar[XB_XGEN(b.x)], 1u);
            asm volatile("s_waitcnt vmcnt(0)" ::: "memory");
        } else {
            XB_SPIN(xb_ld(&bar[XB_XGEN(b.x)]) == gen, bar);
            __builtin_amdgcn_fence(__ATOMIC_ACQUIRE, "agent");
            asm volatile("s_waitcnt vmcnt(0)" ::: "memory");
        }
    }
    __syncthreads();
}

struct Frame {
    LAS unsigned char* lds;
    volatile LAS unsigned* MISC;
    unsigned* ctl;
    int tid, lane, wave, vcu, G, bx;
    const __attribute__((address_space(4))) unsigned char* ka;
    float* out; unsigned char* ws;
};
#define CAS __attribute__((address_space(4)))
#define INP(i) (*(const float* const CAS*)(F.ka + 8 * (i)))
#define WSP(T, off) ((T*)(F.ws + (off)))
#define WSW(off, l) ((bf16*)(F.ws + (off) + (size_t)((l) & 1) * WSET_STRIDE))

__device__ __forceinline__ void conv_item(const float* sp, int ld, const float* gp, bf16* dp, int dpitch, LAS float* scr, int lane) {
    const int kh = lane >> 5, nl = lane & 31;
    float tv[32];
#pragma unroll
    for (int i = 0; i < 32; ++i) tv[i] = sp[(size_t)(2 * i) * ld];
#pragma unroll
    for (int i = 0; i < 32; ++i) { const int kk = 2 * i + kh; float v = tv[i]; if (gp) v *= gp[kk]; scr[kk * 33 + nl] = v; }
    LDS_WAIT(); asm volatile("" ::: "memory");
    const int c = lane & 7;
#pragma unroll
    for (int j = 0; j < 4; ++j) { const int n = (lane >> 3) + 8 * j; const LAS float* s = scr + (8 * c) * 33 + n;
        v4u o; o.x = cvt_pk_bf16(s[0 * 33], s[1 * 33]); o.y = cvt_pk_bf16(s[2 * 33], s[3 * 33]); o.z = cvt_pk_bf16(s[4 * 33], s[5 * 33]); o.w = cvt_pk_bf16(s[6 * 33], s[7 * 33]);
        *(v4u*)(dp + (size_t)n * dpitch + 8 * c) = o; }
    LDS_WAIT(); asm volatile("" ::: "memory");
}
__device__ __forceinline__ void conv_one(Frame& F, int l, int it, LAS float* scr) {
    const int lane = F.lane, kh = lane >> 5, nl = lane & 31;
    const float* w_in = INP(1) + (size_t)l * DM * INW; const float* w_pa = INP(8) + (size_t)l * 512 * DM; const float* w_pb = INP(9) + (size_t)l * 512 * DM;
    const float* w_pc = INP(10) + (size_t)l * 256 * DM; const float* w_o = INP(11) + (size_t)l * DM * DM;
    const float* g1 = INP(12) + l * DM; const float* g2 = INP(13) + l * DM;
    const float* w1 = INP(18) + (size_t)l * 16 * DM * 512; const float* w3 = INP(19) + (size_t)l * 16 * DM * 512; const float* w2 = INP(20) + (size_t)l * 16 * 512 * DM;
    constexpr int I_IN = 16 * 264, I_PA = 8 * 32, I_PC = 4 * 32, I_O = 16 * 32, I_13 = 16 * 512, I_2 = 16 * 256;
    static_assert(CONV_ITEMS == I_IN + 2 * I_PA + I_PC + I_O + I_13 + I_2, "item count");
    {
        int r = it;
        if (r < I_IN) { const int kb = r / 264, nb = r % 264; conv_item(w_in + (size_t)(64 * kb + kh) * INW + 32 * nb + nl, INW, g1 + 64 * kb, WSW(WS_WIN, l) + (size_t)(32 * nb) * 1024 + 64 * kb, 1024, scr, lane); return; } r -= I_IN;
        if (r < I_PA) { const int kb = r / 32, nb = r % 32; conv_item(w_pa + (size_t)(64 * kb + kh) * DM + 32 * nb + nl, DM, nullptr, WSW(WS_WPA, l) + (size_t)(32 * nb) * 512 + 64 * kb, 512, scr, lane); return; } r -= I_PA;
        if (r < I_PA) { const int kb = r / 32, nb = r % 32; conv_item(w_pb + (size_t)(64 * kb + kh) * DM + 32 * nb + nl, DM, nullptr, WSW(WS_WPB, l) + (size_t)(32 * nb) * 512 + 64 * kb, 512, scr, lane); return; } r -= I_PA;
        if (r < I_PC) { const int kb = r / 32, nb = r % 32; conv_item(w_pc + (size_t)(64 * kb + kh) * DM + 32 * nb + nl, DM, nullptr, WSW(WS_WPC, l) + (size_t)(32 * nb) * 256 + 64 * kb, 256, scr, lane); return; } r -= I_PC;
        if (r < I_O)  { const int kb = r / 32, nb = r % 32; conv_item(w_o + (size_t)(64 * kb + kh) * DM + 32 * nb + nl, DM, nullptr, WSW(WS_WO, l) + (size_t)(32 * nb) * 1024 + 64 * kb, 1024, scr, lane); return; } r -= I_O;
        if (r < I_13) { const int e = r / 512, q = r % 512, kb = q / 32, nb = q % 32;
            const float* src = ((nl < 16) ? w1 : w3) + (size_t)e * DM * 512 + (size_t)(64 * kb + kh) * 512 + 16 * nb + (nl & 15);
            conv_item(src, 512, g2 + 64 * kb, WSW(WS_W13, l) + (size_t)(e * 1024 + 32 * nb) * 1024 + 64 * kb, 1024, scr, lane); return; } r -= I_13;
        { const int e = r / 256, q = r % 256, kb = q / 32, nb = q % 32;
            conv_item(w2 + (size_t)e * 512 * DM + (size_t)(64 * kb + kh) * DM + 32 * nb + nl, DM, nullptr, WSW(WS_W2, l) + (size_t)(e * 1024 + 32 * nb) * 512 + 64 * kb, 512, scr, lane); }
    }
}
__device__ __forceinline__ void conv_layer(Frame& F, int l) {
    LAS float* scr = (LAS float*)(F.lds + F.wave * 16384);
    const int gw = F.vcu * NWAVES + F.wave, NGW = F.G * NWAVES;
    for (int it = gw; it < CONV_ITEMS; it += NGW) conv_one(F, l, it, scr);
}
__device__ __forceinline__ void conv_fill(Frame& F, int l, const unsigned* donew) {
    LAS float* scr = (LAS float*)(F.lds + F.wave * 16384);
    unsigned* qh = F.ctl + CW_QHEAD + 64 * l;
    for (;;) {
        __syncthreads();
        if (F.tid == 0) { unsigned base = 0xffffffffu;
            if (__hip_atomic_load(donew, __ATOMIC_RELAXED, __HIP_MEMORY_SCOPE_AGENT) < (unsigned)F.G) base = __hip_atomic_fetch_add(qh, 8u, __ATOMIC_RELAXED, __HIP_MEMORY_SCOPE_AGENT);
            F.MISC[16] = base; }
        __syncthreads();
        const unsigned base = (unsigned)__builtin_amdgcn_readfirstlane((int)F.MISC[16]);
        if (base >= (unsigned)CONV_ITEMS) break;
        const unsigned it = base + F.wave;
        if (it < (unsigned)CONV_ITEMS) conv_one(F, l, (int)it, scr);
    }
}
__device__ __forceinline__ void conv_rest(Frame& F, int l) {
    LAS float* scr = (LAS float*)(F.lds + F.wave * 16384);
    const unsigned h0 = (unsigned)__builtin_amdgcn_readfirstlane((int)__hip_atomic_load(F.ctl + CW_QHEAD + 64 * l, __ATOMIC_RELAXED, __HIP_MEMORY_SCOPE_AGENT));
    const int gw = F.vcu * NWAVES + F.wave, NGW = F.G * NWAVES;
    for (unsigned it = h0 + gw; it < (unsigned)CONV_ITEMS; it += NGW) conv_one(F, l, (int)it, scr);
}
__device__ __forceinline__ void phase_done(Frame& F, int ph) { __syncthreads(); if (F.tid == 0) __hip_atomic_fetch_add(F.ctl + CW_DONE + 64 * ph, 1u, __ATOMIC_RELAXED, __HIP_MEMORY_SCOPE_AGENT); }
__device__ __forceinline__ void router_tables(Frame& F) {
    float* rt = WSP(float, WS_RT);
    for (int idx = F.bx * 512 + F.tid; idx < DEPTH * 20 * DM; idx += F.G * 512) { const int l = idx / (20 * DM), c = (idx / DM) % 20, k = idx % DM;
        rt[idx] = INP(13)[l * DM + k] * ((c < 4) ? INP(14)[((size_t)l * DM + k) * 4 + c] : INP(16)[((size_t)l * DM + k) * 16 + (c - 4)]); }
}
__device__ __forceinline__ void rope_tables(Frame& F) {
    const double inv[8] = {1.0, 0.19392274474868576, 0.03760603093086393, 0.007292664737217109, 0.001414213562373095, 0.0002742481756762073, 5.318295896944988e-05, 1.031338537721246e-05};
    float* rc = WSP(float, WS_ROPEC); float* rsn = WSP(float, WS_ROPES);
    for (int idx = F.bx * 512 + F.tid; idx < SEQ * 8; idx += F.G * 512) {
        const int t = idx >> 3, i = idx & 7;
        double f = 1.0; f = (i == 1) ? inv[1] : f; f = (i == 2) ? inv[2] : f; f = (i == 3) ? inv[3] : f; f = (i == 4) ? inv[4] : f; f = (i == 5) ? inv[5] : f; f = (i == 6) ? inv[6] : f; f = (i == 7) ? inv[7] : f;
        const double rev = (double)t * f * 0.15915494309189535;
        const float fr = (float)(rev - __builtin_rint(rev));
        rc[idx] = __builtin_amdgcn_cosf(fr); rsn[idx] = __builtin_amdgcn_sinf(fr);
    }
}
__device__ __forceinline__ f32x4 bf4(v2u w) { return (f32x4){pg8::bf_lo(w.x), pg8::bf_hi(w.x), pg8::bf_lo(w.y), pg8::bf_hi(w.y)}; }
__device__ __forceinline__ void norm_rows(Frame& F, const float* src, float* copy, float* rs, const bf16* cb) {
    const int gw = F.vcu * NWAVES + F.wave, NGW = F.G * NWAVES;
    bf16* abf = WSP(bf16, WS_ABF);
    for (int m0 = gw; m0 < NTOK; m0 += 4 * NGW) {
        f32x4 v[4][4];
#pragma unroll
        for (int q = 0; q < 4; ++q) { const f32x4* xr = (const f32x4*)(src + (size_t)(m0 + q * NGW) * DM) + F.lane;
#pragma unroll
            for (int j = 0; j < 4; ++j) v[q][j] = xr[64 * j]; }
        if (cb) { v2u c0[4][4], c1[4][4];
#pragma unroll
            for (int q = 0; q < 4; ++q) { const int m = m0 + q * NGW; const v2u* p0 = (const v2u*)(cb + (size_t)(2 * m) * DM) + F.lane; const v2u* p1 = (const v2u*)(cb + (size_t)(2 * m + 1) * DM) + F.lane;
#pragma unroll
                for (int j = 0; j < 4; ++j) { c0[q][j] = p0[64 * j]; c1[q][j] = p1[64 * j]; } }
#pragma unroll
            for (int q = 0; q < 4; ++q)
#pragma unroll
                for (int j = 0; j < 4; ++j) v[q][j] = (v[q][j] + bf4(c0[q][j])) + bf4(c1[q][j]); }
#pragma unroll
        for (int q = 0; q < 4; ++q) { const int m = m0 + q * NGW; float s = 0.f;
#pragma unroll
            for (int j = 0; j < 4; ++j) s += (v[q][j].x * v[q][j].x + v[q][j].y * v[q][j].y) + (v[q][j].z * v[q][j].z + v[q][j].w * v[q][j].w);
            const float r = 1.0f / sqrtf(wave_sum(s) * (1.0f / DM) + 1e-6f);
            if (F.lane == 0) rs[m] = r;
            v2u* o8 = (v2u*)(abf + (size_t)m * DM) + F.lane;
#pragma unroll
            for (int j = 0; j < 4; ++j) { v2u w; w.x = cvt_pk_bf16(v[q][j].x, v[q][j].y); w.y = cvt_pk_bf16(v[q][j].z, v[q][j].w); o8[64 * j] = w; }
            if (copy) { f32x4* c = (f32x4*)(copy + (size_t)m * DM) + F.lane;
#pragma unroll
                for (int j = 0; j < 4; ++j) c[64 * j] = v[q][j]; } }
    }
}
__device__ __forceinline__ void norm_route(Frame& F, int l, bool append) {
    const int gw = F.vcu * NWAVES + F.wave, NGW = F.G * NWAVES, lane = F.lane;
    LAS float* wt = (LAS float*)F.lds;
    const float* bg = INP(15) + l * 4; const float* be = INP(17) + l * 16;
    { const f32x4* rt = (const f32x4*)(WSP(float, WS_RT) + (size_t)l * 20 * DM); f32x4 tv[10];
#pragma unroll
      for (int i = 0; i < 10; ++i) tv[i] = rt[F.tid + 512 * i];
#pragma unroll
      for (int i = 0; i < 10; ++i) *(LAS f32x4*)(wt + 4 * (F.tid + 512 * i)) = tv[i]; }
    LAS unsigned* pe = (LAS unsigned*)(F.lds + 98304); LAS unsigned* pent = pe + 128; LAS unsigned* plp = pe + 256; LAS unsigned* lcount = pe + 384; LAS unsigned* lbase = pe + 400;
    if (F.tid < 16) lcount[F.tid] = 0u;
    __syncthreads();
    int jj = 0;
    float bias[20];
#pragma unroll
    for (int c = 0; c < 20; ++c) bias[c] = (c < 4) ? bg[c] : be[c - 4];
    bf16* abf = WSP(bf16, WS_ABF); float* rs = WSP(float, WS_RS2); float* comb = WSP(float, WS_COMB); const float* src = F.out;
    for (int m0 = gw; m0 < NTOK; m0 += 4 * NGW) {
      f32x4 vq[4][4];
#pragma unroll
      for (int q = 0; q < 4; ++q) { const f32x4* xr = (const f32x4*)(src + (size_t)(m0 + q * NGW) * DM) + lane;
#pragma unroll
          for (int j = 0; j < 4; ++j) vq[q][j] = xr[64 * j]; }
#pragma unroll
      for (int q = 0; q < 4; ++q) {
        const int m = m0 + q * NGW; f32x4 v[4]; float s = 0.f;
#pragma unroll
        for (int j = 0; j < 4; ++j) { v[j] = vq[q][j]; s += (v[j].x * v[j].x + v[j].y * v[j].y) + (v[j].z * v[j].z + v[j].w * v[j].w); }
        const float r = 1.0f / sqrtf(wave_sum(s) * (1.0f / DM) + 1e-6f);
        if (lane == 0) rs[m] = r;
        v2u* o8 = (v2u*)(abf + (size_t)m * DM) + lane;
#pragma unroll
        for (int j = 0; j < 4; ++j) { v2u w; w.x = cvt_pk_bf16(v[j].x, v[j].y); w.y = cvt_pk_bf16(v[j].z, v[j].w); o8[64 * j] = w; }
        float lg[20];
#pragma unroll
        for (int c = 0; c < 20; ++c) { float a = 0.f;
#pragma unroll
            for (int j = 0; j < 4; ++j) { const f32x4 w = *(const LAS f32x4*)(wt + c * 1024 + 256 * j + 4 * lane); a += (v[j].x * w.x + v[j].y * w.y) + (v[j].z * w.z + v[j].w * w.w); }
            lg[c] = wave_sum(a) * r + bias[c]; }
        int gs = 0; float gm = lg[0];
#pragma unroll
        for (int j = 1; j < 4; ++j) if (lg[j] > gm) { gm = lg[j]; gs = j; }
        float gden = 0.f;
#pragma unroll
        for (int j = 0; j < 4; ++j) gden += __builtin_amdgcn_exp2f((lg[j] - gm) * LOG2E);
        const float ggate = 1.0f / gden;
        float el[4];
#pragma unroll
        for (int j = 0; j < 4; ++j) el[j] = (gs == 0) ? lg[4 + j] : (gs == 1) ? lg[8 + j] : (gs == 2) ? lg[12 + j] : lg[16 + j];
        int t1 = 0; float v1 = el[0];
#pragma unroll
        for (int j = 1; j < 4; ++j) if (el[j] > v1) { v1 = el[j]; t1 = j; }
        int t2 = -1; float v2 = -3.0e38f;
#pragma unroll
        for (int j = 0; j < 4; ++j) if (j != t1 && el[j] > v2) { v2 = el[j]; t2 = j; }
        if (t2 < 0) t2 = (t1 == 0) ? 1 : 0;
        const float ex = __builtin_amdgcn_exp2f((v2 - v1) * LOG2E), w1 = ggate / (1.0f + ex), w2 = ggate * ex / (1.0f + ex);
        const int e1 = gs * 4 + t1, e2 = gs * 4 + t2;
        if (lane < 16) comb[(size_t)m * 16 + lane] = (lane == e1) ? w1 : (lane == e2) ? w2 : 0.f;
        if (lane < 2 && jj < 8) { const int e = (lane == 0) ? e1 : e2, slot = F.wave * 16 + jj * 2 + lane;
            pe[slot] = (unsigned)e; pent[slot] = (unsigned)(2 * m + lane); plp[slot] = __hip_atomic_fetch_add(lcount + e, 1u, __ATOMIC_RELAXED, __HIP_MEMORY_SCOPE_WORKGROUP); }
        ++jj;
      }
    }
    __syncthreads();
    unsigned* gcnt = F.ctl + CW_CNT + l * 1024; unsigned* list = WSP(unsigned, WS_LIST);
    if (F.tid < 16 && append) lbase[F.tid] = __hip_atomic_fetch_add(gcnt + 64 * F.tid, lcount[F.tid], __ATOMIC_RELAXED, __HIP_MEMORY_SCOPE_AGENT);
    __syncthreads();
    if (F.tid < 128 && append) { const unsigned e = pe[F.tid]; list[e * 16384 + lbase[e] + plp[F.tid]] = pent[F.tid]; }
    __syncthreads();
}
__device__ __forceinline__ void final_norm(Frame& F) {
    const int gw = F.vcu * NWAVES + F.wave, NGW = F.G * NWAVES; const float* gf = INP(21); const bf16* cb = WSP(bf16, WS_CB);
    f32x4 g[4];
#pragma unroll
    for (int j = 0; j < 4; ++j) g[j] = *((const f32x4*)gf + F.lane + 64 * j);
    for (int m = gw; m < NTOK; m += NGW) {
        f32x4* xr = (f32x4*)(F.out + (size_t)m * DM) + F.lane; f32x4 v[4]; float s = 0.f;
        const v2u* c0 = (const v2u*)(cb + (size_t)(2 * m) * DM) + F.lane; const v2u* c1 = (const v2u*)(cb + (size_t)(2 * m + 1) * DM) + F.lane;
#pragma unroll
        for (int j = 0; j < 4; ++j) { v[j] = (xr[64 * j] + bf4(c0[64 * j])) + bf4(c1[64 * j]); s += (v[j].x * v[j].x + v[j].y * v[j].y) + (v[j].z * v[j].z + v[j].w * v[j].w); }
        const float r = 1.0f / sqrtf(wave_sum(s) * (1.0f / DM) + 1e-6f);
#pragma unroll
        for (int j = 0; j < 4; ++j) xr[64 * j] = v[j] * r * g[j];
    }
}

#define MFMA32(a, b, c) __builtin_amdgcn_mfma_f32_32x32x16_bf16((a), (b), (c), 0, 0, 0)
#define MFMA16(a, b, c) __builtin_amdgcn_mfma_f32_16x16x32_bf16((a), (b), (c), 0, 0, 0)
__device__ __forceinline__ bf16x8 pack8(float a0, float a1, float a2, float a3, float a4, float a5, float a6, float a7) {
    v4u w; w.x = cvt_pk_bf16(a0, a1); w.y = cvt_pk_bf16(a2, a3); w.z = cvt_pk_bf16(a4, a5); w.w = cvt_pk_bf16(a6, a7); return __builtin_bit_cast(bf16x8, w);
}
__device__ __forceinline__ bf16x8 cat44(s16x4 lo, s16x4 hi) { return (bf16x8){lo[0], lo[1], lo[2], lo[3], hi[0], hi[1], hi[2], hi[3]}; }

__device__ __forceinline__ float max3f(float a, float b, float c) { return fmaxf(fmaxf(a, b), c); }
__device__ __forceinline__ void glds16(const void* gsrc, unsigned lds_dst) { unsigned keep;
    asm volatile("s_mov_b32 %0, m0\n\ts_mov_b32 m0, %2\n\ts_nop 0\n\tglobal_load_lds_dwordx4 %1, off\n\ts_mov_b32 m0, %0" : "=&s"(keep) : "v"(gsrc), "s"(lds_dst) : "memory"); }
__device__ __forceinline__ void diff_unit(LAS unsigned char* lds, const bf16* __restrict__ QB, bf16* __restrict__ YB, float* __restrict__ stash, int b, int h, int qb, float lam, float post, const float* __restrict__ subg) {
    constexpr float THR = 8.0f;
    const int tid = pg8::opq_tid(), lane = tid & 63, wid = __builtin_amdgcn_readfirstlane(tid >> 6), r32 = lane & 31, hi = lane >> 5;
    const size_t rowq = (size_t)b * SEQ + qb * 256 + wid * 32 + r32;
    LAS unsigned char* Kb = lds; LAS unsigned char* Vb = lds + 16384;
    const int kkey = 8 * wid + (lane >> 3), kc = (lane & 7) ^ (kkey & 7);
    size_t voff[2];
#pragma unroll
    for (int j = 0; j < 2; ++j) { const int vk = 4 * (2 * wid + j) + (lane >> 4), vc = (lane & 15) ^ ((vk & 3) << 2); voff[j] = ((size_t)b * SEQ + vk) * 1536 + 1024 + h * 128 + vc * 8; }
    const int dvhalf = (lane >> 4) & 1, i16 = lane & 15, q_ = i16 >> 2, p_ = i16 & 3;
    const unsigned vrd = (4 * hi + q_) * 256 + 32 * dvhalf + 8 * p_;
    const unsigned krd = r32 * 128;
    f32x4* st = (f32x4*)(stash + ((size_t)wid * 64 + lane) * 64);
    const unsigned kdst0 = (unsigned)(uintptr_t)Kb + wid * 1024, vdst0 = (unsigned)(uintptr_t)Vb + (2 * wid) * 1024;
#define DF_STAGE_K(t_, buf_) glds16(ksrc + (size_t)(t_) * 64 * 1536, (unsigned)__builtin_amdgcn_readfirstlane(kdst0 + (buf_) * 8192))
#define DF_STAGE_V(t_, buf_) do { const size_t adv_ = (size_t)(t_) * 64 * 1536; \
        glds16(QB + voff[0] + adv_, (unsigned)__builtin_amdgcn_readfirstlane(vdst0 + (buf_) * 16384)); \
        glds16(QB + voff[1] + adv_, (unsigned)__builtin_amdgcn_readfirstlane(vdst0 + (buf_) * 16384 + 1024)); } while (0)
#define DF_QKT(P0, P1, kb_) do { const LAS unsigned char* Kc_ = Kb + (kb_) * 8192; P0 = (f32x16){}; P1 = (f32x16){}; \
        _Pragma("unroll") for (int ks = 0; ks < 4; ++ks) { const unsigned o_ = krd + (((2 * ks + hi) ^ (r32 & 7)) << 4); \
            const bf16x8 a0_ = *(const LAS bf16x8*)(Kc_ + o_), a1_ = *(const LAS bf16x8*)(Kc_ + 4096 + o_); \
            P0 = MFMA32(a0_, qf[ks], P0); P1 = MFMA32(a1_, qf[ks], P1); } } while (0)
#define DF_DECIDE(mx_, first_) do { const float mxl_ = (mx_) - m_run; \
        if ((first_) || __any(mxl_ > THR)) { const float rm_ = fmaxf(mxl_, __shfl_xor(mxl_, 32)); \
            const float dl_ = (first_) ? rm_ : fmaxf(rm_, 0.f), f_ = (first_) ? 1.0f : __builtin_amdgcn_exp2f(-dl_); \
            m_run += dl_; l_run *= f_; \
            _Pragma("unroll") for (int k = 0; k < 4; ++k) O[k] = O[k] * f_; } } while (0)
#define DF_SB __builtin_amdgcn_sched_barrier(0)
#define DF_VR(i_) do { const unsigned o_ = vrd + ((i_) >> 2) * 4096 + ((((i_) & 3) ^ q_) << 6); vl[(i_) & 3] = vtr(Vc_ + o_); vh[(i_) & 3] = vtr(Vc_ + o_ + 2048); } while (0)
#define DF_EX(X, r_) do { X[r_] = __builtin_amdgcn_exp2f(X[r_] - m_run); ls_ += X[r_]; } while (0)
#define DF_STEP(C0, C1, N0, N1, t_, HAS_K2, HAS_N) do { const int t = (t_); \
        if (HAS_K2) DF_STAGE_K(t + 2, t & 1); \
        if (HAS_N) DF_STAGE_V(t + 1, (t + 1) & 1); \
        const LAS unsigned char* Kc_ = Kb + ((t + 1) & 1) * 8192; const LAS unsigned char* Vc_ = Vb + (t & 1) * 16384; \
        bf16x8 ka_[8]; s16x4 vl[4], vh[4]; float ls_ = 0.f; \
        if (HAS_N) { _Pragma("unroll") for (int ks = 0; ks < 4; ++ks) { const unsigned o_ = krd + (((2 * ks + hi) ^ (r32 & 7)) << 4); ka_[2 * ks] = *(const LAS bf16x8*)(Kc_ + o_); ka_[2 * ks + 1] = *(const LAS bf16x8*)(Kc_ + 4096 + o_); } } \
        DF_VR(0); DF_VR(1); DF_SB; \
        _Pragma("unroll") for (int ks = 0; ks < 4; ++ks) { \
            if (HAS_N) { if (ks == 0) { N0 = MFMA32(ka_[0], qf[0], (f32x16){}); N1 = MFMA32(ka_[1], qf[0], (f32x16){}); } else { N0 = MFMA32(ka_[2 * ks], qf[ks], N0); N1 = MFMA32(ka_[2 * ks + 1], qf[ks], N1); } } \
            DF_EX(C0, 4 * ks); DF_EX(C0, 4 * ks + 1); DF_EX(C0, 4 * ks + 2); DF_EX(C0, 4 * ks + 3); DF_SB; } \
        bf16x8 pb[4]; \
        pb[0] = pack8(C0[0], C0[1], C0[2], C0[3], C0[4], C0[5], C0[6], C0[7]); pb[1] = pack8(C0[8], C0[9], C0[10], C0[11], C0[12], C0[13], C0[14], C0[15]); DF_SB; \
        _Pragma("unroll") for (int i = 0; i < 8; ++i) { DF_VR(i + 2); O[i & 3] = MFMA32(cat44(vl[i & 3], vh[i & 3]), pb[i >> 2], O[i & 3]); DF_EX(C1, 2 * i); DF_EX(C1, 2 * i + 1); DF_SB; } \
        pb[2] = pack8(C1[0], C1[1], C1[2], C1[3], C1[4], C1[5], C1[6], C1[7]); pb[3] = pack8(C1[8], C1[9], C1[10], C1[11], C1[12], C1[13], C1[14], C1[15]); DF_SB; \
        float ma_ = -3.0e38f, mb_ = -3.0e38f; \
        _Pragma("unroll") for (int i = 8; i < 16; ++i) { if (i + 2 < 16) DF_VR(i + 2); O[i & 3] = MFMA32(cat44(vl[i & 3], vh[i & 3]), pb[i >> 2], O[i & 3]); \
            if (HAS_N) { ma_ = max3f(ma_, N0[2 * (i - 8)], N0[2 * (i - 8) + 1]); mb_ = max3f(mb_, N1[2 * (i - 8)], N1[2 * (i - 8) + 1]); } DF_SB; } \
        l_run += ls_; \
        if (HAS_N) DF_DECIDE(fmaxf(ma_, mb_), false); \
        VM_WAIT(); __syncthreads(); } while (0)
#pragma unroll 1
    for (int c = 0; c < 2; ++c) {
        const int i = 2 * h + c;
        bf16x8 qf[4];
#pragma unroll
        for (int ks = 0; ks < 4; ++ks) qf[ks] = *(const bf16x8*)(QB + rowq * 1536 + i * 64 + ks * 16 + hi * 8);
        f32x16 O[4];
#pragma unroll
        for (int k = 0; k < 4; ++k) O[k] = (f32x16){};
        float m_run = 0.f, l_run = 0.f;
        const bf16* ksrc = QB + ((size_t)b * SEQ + kkey) * 1536 + 512 + i * 64 + kc * 8;
        __syncthreads();
        DF_STAGE_K(0, 0); DF_STAGE_V(0, 0); DF_STAGE_K(1, 1);
        VM_WAIT(); __syncthreads();
        f32x16 pA0, pA1, pB0, pB1;
        DF_QKT(pA0, pA1, 0);
        { float ma_ = max3f(pA0[0], pA0[1], pA1[0]), mb_ = max3f(pA0[2], pA0[3], pA1[1]); ma_ = max3f(ma_, pA1[2], pA1[3]);
#pragma unroll
          for (int r = 4; r < 16; r += 4) { ma_ = max3f(ma_, pA0[r], pA0[r + 1]); mb_ = max3f(mb_, pA0[r + 2], pA0[r + 3]); ma_ = max3f(ma_, pA1[r], pA1[r + 1]); mb_ = max3f(mb_, pA1[r + 2], pA1[r + 3]); }
          DF_DECIDE(fmaxf(ma_, mb_), true); }
        __syncthreads();
#pragma unroll 1
        for (int t2 = 0; t2 < 62; t2 += 2) {
            DF_STEP(pA0, pA1, pB0, pB1, t2, true, true);
            DF_STEP(pB0, pB1, pA0, pA1, t2 + 1, true, true);
        }
        DF_STEP(pA0, pA1, pB0, pB1, 62, false, true);
        DF_STEP(pB0, pB1, pA0, pA1, 63, false, false);
        const float inv = 1.0f / (l_run + __shfl_xor(l_run, 32));
        if (c == 0) {
#pragma unroll
            for (int k = 0; k < 4; ++k)
#pragma unroll
                for (int r4 = 0; r4 < 4; ++r4) st[k * 4 + r4] = (f32x4){O[k][4 * r4] * inv, O[k][4 * r4 + 1] * inv, O[k][4 * r4 + 2] * inv, O[k][4 * r4 + 3] * inv};
        } else {
            float ss = 0.f;
#pragma unroll
            for (int k = 0; k < 4; ++k)
#pragma unroll
                for (int r4 = 0; r4 < 4; ++r4) { const f32x4 o0 = st[k * 4 + r4];
#pragma unroll
                    for (int j = 0; j < 4; ++j) { const float d = o0[j] - lam * (O[k][4 * r4 + j] * inv); O[k][4 * r4 + j] = d; ss += d * d; } }
            ss += __shfl_xor(ss, 32);
            const float rn = post / sqrtf(ss * (1.0f / 128.0f) + 1e-5f);
            bf16* yp = YB + rowq * 512 + h * 128;
#pragma unroll
            for (int k = 0; k < 4; ++k)
#pragma unroll
                for (int r4 = 0; r4 < 4; ++r4) { const int dv = k * 32 + 8 * r4 + 4 * hi; const f32x4 g = *(const f32x4*)(subg + dv);
                    v2u w; w.x = cvt_pk_bf16(O[k][4 * r4] * rn * g.x, O[k][4 * r4 + 1] * rn * g.y); w.y = cvt_pk_bf16(O[k][4 * r4 + 2] * rn * g.z, O[k][4 * r4 + 3] * rn * g.w);
                    *(v2u*)(yp + dv) = w; }
        }
    }
#undef DF_STAGE_K
#undef DF_STAGE_V
#undef DF_QKT
#undef DF_DECIDE
#undef DF_STEP
#undef DF_SB
#undef DF_VR
#undef DF_EX
}

template <int NKT, int VAR, class KeyTok, class Bias>
__device__ __forceinline__ void win_tile(LAS unsigned char* vbuf, const bf16* __restrict__ X, int pitch, size_t tq, int qcol, int kcol, int vcol, const KeyTok& keytok, const Bias& biasf,
                                         f32x4 (&O)[4], float& m_out, float& l_out, int lane) {
    const int qi = lane & 15, g = lane >> 4, q_ = qi >> 2, p_ = qi & 3;
    bf16x8 qf[2];
#pragma unroll
    for (int ks = 0; ks < 2; ++ks) qf[ks] = *(const bf16x8*)(X + tq * pitch + qcol + 32 * ks + 8 * g);
    f32x4 s[NKT];
#pragma unroll
    for (int kt = 0; kt < NKT; ++kt) {
        const size_t tk = keytok(kt * 16 + qi);
        const bf16x8 k0 = (VAR & 4) ? qf[0] : *(const bf16x8*)(X + tk * pitch + kcol + 8 * g), k1 = (VAR & 4) ? qf[1] : *(const bf16x8*)(X + tk * pitch + kcol + 32 + 8 * g);
        f32x4 a = (f32x4){0.f, 0.f, 0.f, 0.f}; a = MFMA16(k0, qf[0], a); a = MFMA16(k1, qf[1], a);
#pragma unroll
        for (int r = 0; r < 4; ++r) s[kt][r] = (VAR & 1) ? a[r] : biasf(kt, 4 * g + r, a[r]);
    }
    constexpr int NS = NKT / 2;
    v4u vA[4][4], vB[4][4];
#define WT_VLOAD(dst, st_) do { _Pragma("unroll") for (int j = 0; j < 4; ++j) { const int idx = lane + 64 * j, key = idx >> 3, ch = idx & 7; const size_t tv = keytok((st_) * 32 + key); dst[j] = *(const v4u*)(X + tv * pitch + vcol + ch * 8); } } while (0)
#pragma unroll
    for (int q = 0; q < 4; ++q) if (q < NS && !(VAR & 2)) WT_VLOAD(vA[q], q);
    float mx = -1.0e30f;
#pragma unroll
    for (int kt = 0; kt < NKT; ++kt)
#pragma unroll
        for (int r = 0; r < 4; ++r) mx = fmaxf(mx, s[kt][r]);
    mx = fmaxf(mx, __shfl_xor(mx, 16)); mx = fmaxf(mx, __shfl_xor(mx, 32));
    float l = 0.f;
#pragma unroll
    for (int kt = 0; kt < NKT; ++kt)
#pragma unroll
        for (int r = 0; r < 4; ++r) { s[kt][r] = __builtin_amdgcn_exp2f(s[kt][r] - mx); l += s[kt][r]; }
    l += __shfl_xor(l, 16); l += __shfl_xor(l, 32);
    m_out = mx; l_out = l;
#pragma unroll
    for (int dt = 0; dt < 4; ++dt) O[dt] = (f32x4){0.f, 0.f, 0.f, 0.f};
    const int k0r = 4 * g + q_, k1r = 16 + 4 * g + q_;
    const unsigned rd0 = k0r * 128 + ((8 * p_) ^ (((k0r >> 1) & 3) << 5)), rd1 = k1r * 128 + ((8 * p_) ^ (((k1r >> 1) & 3) << 5));
#pragma unroll
    for (int st = 0; st < ((VAR & 2) ? 0 : NS); ++st) {
        LAS unsigned char* vb = vbuf + (st & 1) * 4096;
#pragma unroll
        for (int j = 0; j < 4; ++j) { const int idx = lane + 64 * j, key = idx >> 3, ch = idx & 7; const v4u val = (st & 4) ? vB[st & 3][j] : vA[st & 3][j];
            *(LAS v4u*)(vb + key * 128 + ((ch * 16) ^ (((key >> 1) & 3) << 5))) = val; }
        asm volatile("" ::: "memory");
        if (st == 0) {
#pragma unroll
            for (int q = 0; q < 4; ++q) if (4 + q < NS) WT_VLOAD(vB[q], 4 + q);
        }
        LDS_WAIT();
        const bf16x8 pb = pack8(s[2 * st][0], s[2 * st][1], s[2 * st][2], s[2 * st][3], s[2 * st + 1][0], s[2 * st + 1][1], s[2 * st + 1][2], s[2 * st + 1][3]);
#pragma unroll
        for (int dt = 0; dt < 4; ++dt) { const s16x4 lo = vtr(vb + (rd0 ^ (dt << 5))), hh = vtr(vb + (rd1 ^ (dt << 5))); O[dt] = MFMA16(cat44(lo, hh), pb, O[dt]); }
    }
    LDS_WAIT();
#undef WT_VLOAD
}

__device__ __forceinline__ void na_band(LAS unsigned char* lds, const LAS float* btab, const bf16* __restrict__ QA, bf16* __restrict__ YA, int b, int h, int band, int wave, int lane) {
    const int qi = lane & 15, g = lane >> 4, q_ = qi >> 2, p_ = qi & 3;
    LAS unsigned char* Kr = lds; LAS unsigned char* Vr = lds + 73728;
    const unsigned kr0 = (unsigned)(uintptr_t)Kr, vr0 = (unsigned)(uintptr_t)Vr;
    const int R0 = 8 * band; int loaded_hi = ((R0 - 4) < 0 ? 0 : ((R0 - 4) > 56 ? 56 : (R0 - 4))) - 1;
    const LAS float* tab = btab + h * 465;
    const int dtok = lane >> 3, pc = lane & 7;
#pragma unroll 1
    for (int pr = 0; pr < 4; ++pr) {
        const int r = R0 + 2 * pr, rq = r + (wave >> 2), cb = wave & 3;
        const int r0n = (r + 1 - 4) < 0 ? 0 : ((r + 1 - 4) > 56 ? 56 : (r + 1 - 4)), need_hi = r0n + 7;
        const int r0 = (rq - 4) < 0 ? 0 : ((rq - 4) > 56 ? 56 : (rq - 4));
        const int cs = (cb == 0) ? 0 : (cb == 1) ? 8 : (cb == 2) ? 24 : 32;
        const int qc = cb * 16 + qi, c0 = (qc - 8) < 0 ? 0 : ((qc - 8) > 48 ? 48 : (qc - 8));
        const size_t tq = (size_t)b * SEQ + rq * 64 + qc;
        bf16x8 qf[2];
#pragma unroll
        for (int ks = 0; ks < 2; ++ks) qf[ks] = *(const bf16x8*)(QA + tq * 1536 + h * 64 + 32 * ks + 8 * g);
        __syncthreads();
        { const int np = 16 * (need_hi - loaded_hi);
#pragma unroll 1
          for (int pp = wave; pp < np; pp += 8) { const int row = loaded_hi + 1 + (pp >> 4), isv = (pp >> 3) & 1, piece = pp & 7, token = 8 * piece + dtok;
              const int c = isv ? (pc ^ (((token >> 1) & 3) << 1)) : (pc ^ (token & 7));
              const bf16* src = QA + ((size_t)b * SEQ + row * 64 + token) * 1536 + (isv ? 1024 : 512) + h * 64 + c * 8;
              glds16(src, (unsigned)__builtin_amdgcn_readfirstlane((isv ? vr0 : kr0) + (row % 9) * 8192 + piece * 1024)); } }
        loaded_hi = need_hi;
        VM_WAIT(); __syncthreads();
        f32x4 s[16];
#pragma unroll
        for (int kt = 0; kt < 16; ++kt) { const int grow = r0 + (kt >> 1), col = cs + (kt & 1) * 16 + qi;
            const LAS unsigned char* kp = Kr + (grow % 9) * 8192 + col * 128;
            const bf16x8 k0 = *(const LAS bf16x8*)(kp + ((g ^ (col & 7)) << 4)), k1 = *(const LAS bf16x8*)(kp + (((4 + g) ^ (col & 7)) << 4));
            f32x4 a = (f32x4){0.f, 0.f, 0.f, 0.f}; a = MFMA16(k0, qf[0], a); a = MFMA16(k1, qf[1], a);
            const int dr = r0 - rq + 7 + (kt >> 1);
#pragma unroll
            for (int rr = 0; rr < 4; ++rr) { const int kc = cs + (kt & 1) * 16 + 4 * g + rr, dc = kc - qc + 15; const bool ok = (kc >= c0) && (kc < c0 + 16); const int dcc = dc < 0 ? 0 : (dc > 30 ? 30 : dc);
                s[kt][rr] = ok ? a[rr] + tab[dr * 31 + dcc] : -1.0e30f; } }
        float mx = -1.0e30f;
#pragma unroll
        for (int kt = 0; kt < 16; ++kt)
#pragma unroll
            for (int rr = 0; rr < 4; ++rr) mx = fmaxf(mx, s[kt][rr]);
        mx = fmaxf(mx, __shfl_xor(mx, 16)); mx = fmaxf(mx, __shfl_xor(mx, 32));
        float l = 0.f;
#pragma unroll
        for (int kt = 0; kt < 16; ++kt)
#pragma unroll
            for (int rr = 0; rr < 4; ++rr) { s[kt][rr] = __builtin_amdgcn_exp2f(s[kt][rr] - mx); l += s[kt][rr]; }
        l += __shfl_xor(l, 16); l += __shfl_xor(l, 32);
        f32x4 O[4];
#pragma unroll
        for (int dt = 0; dt < 4; ++dt) O[dt] = (f32x4){0.f, 0.f, 0.f, 0.f};
        const int c0v = cs + 4 * g + q_, c1v = c0v + 16;
        const unsigned rd0 = c0v * 128 + ((8 * p_) ^ (((c0v >> 1) & 3) << 5)), rd1 = c1v * 128 + ((8 * p_) ^ (((c1v >> 1) & 3) << 5));
#pragma unroll
        for (int st = 0; st < 8; ++st) { const LAS unsigned char* vb = Vr + ((r0 + st) % 9) * 8192;
            const bf16x8 pb = pack8(s[2 * st][0], s[2 * st][1], s[2 * st][2], s[2 * st][3], s[2 * st + 1][0], s[2 * st + 1][1], s[2 * st + 1][2], s[2 * st + 1][3]);
#pragma unroll
            for (int dt = 0; dt < 4; ++dt) { const s16x4 lo = vtr(vb + (rd0 ^ (dt << 5))), hh = vtr(vb + (rd1 ^ (dt << 5))); O[dt] = MFMA16(cat44(lo, hh), pb, O[dt]); } }
        const float inv = 1.0f / l;
#pragma unroll
        for (int dt = 0; dt < 4; ++dt) { v2u w; w.x = cvt_pk_bf16(O[dt][0] * inv, O[dt][1] * inv); w.y = cvt_pk_bf16(O[dt][2] * inv, O[dt][3] * inv);
            *(v2u*)(YA + tq * 512 + h * 64 + 16 * dt + 4 * g) = w; }
    }
    __syncthreads();
}

#ifndef FILL_MASK
#define FILL_MASK 7
#endif
#ifndef REP_G3
#define REP_G3 1
#endif
#ifndef REP_BAR
#define REP_BAR 1
#endif
#ifndef REP_N2
#define REP_N2 1
#endif
#ifndef REP_NR
#define REP_NR 1
#endif
#ifndef REP_G2
#define REP_G2 1
#endif
#ifndef REP_M2
#define REP_M2 1
#endif
#ifndef REP_CONV
#define REP_CONV 1
#endif
#ifndef REP_DIFF
#define REP_DIFF 1
#endif
#ifndef REP_G1
#define REP_G1 1
#endif
#ifndef REP_M1
#define REP_M1 1
#endif
#ifndef REP_NA
#define REP_NA 1
#endif
#ifndef REP_DIL
#define REP_DIL 1
#endif
#ifndef ATTMASK
#define ATTMASK 7
#endif
__device__ __forceinline__ unsigned long long opq64(unsigned long long v) { unsigned lo = __builtin_amdgcn_readfirstlane((unsigned)v), hi = __builtin_amdgcn_readfirstlane((unsigned)(v >> 32)); asm volatile("" : "+s"(lo), "+s"(hi)); return ((unsigned long long)hi << 32) | lo; }
template <class T> __device__ __forceinline__ T* opq(T* p) { return (T*)opq64((unsigned long long)p); }
struct NaKey { size_t base; int cs; __device__ __forceinline__ size_t operator()(int kk) const { return base + (size_t)((kk >> 5) * 64 + cs + (kk & 31)); } };
struct NaBias { const LAS float* tab; int cs, qc, c0, drb;
    __device__ __forceinline__ float operator()(int kt, int kin, float a) const {
        const int kc = cs + (kt & 1) * 16 + kin, dr = drb + (kt >> 1), dc = kc - qc + 15; const bool ok = (kc >= c0) && (kc < c0 + 16);
        const int dcc = dc < 0 ? 0 : (dc > 30 ? 30 : dc); return ok ? a + tab[dr * 31 + dcc] : -1.0e30f; } };
struct DilKey { size_t base; int l0, dil, L; __device__ __forceinline__ size_t operator()(int kk) const { int lk = l0 - 64 + kk; lk = lk < 0 ? 0 : (lk > L - 1 ? L - 1 : lk); return base + (size_t)lk * dil; } };
struct DilBias { int l0, L, lq;
    __device__ __forceinline__ float operator()(int kt, int kin, float a) const { const int lk = l0 - 64 + kt * 16 + kin, d = lk - lq; const bool ok = (lk >= 0) && (lk < L) && (d <= 64) && (d >= -64); return ok ? a : -1.0e30f; } };

__device__ __forceinline__ void att_phase(Frame& F, int l) {
    const int lane = F.lane, wave = F.wave, qi = lane & 15, g = lane >> 4;
    const float lam_init = (l == 0) ? 0.2f : (l == 1) ? 0.35550906759096934f : (l == 2) ? 0.4707130183435842f : 0.5560582041556406f;
    const float d1 = wave_sum(INP(3)[l * 64 + lane] * INP(4)[l * 64 + lane]), d2 = wave_sum(INP(5)[l * 64 + lane] * INP(6)[l * 64 + lane]);
    const float lam = __builtin_amdgcn_exp2f(d1 * LOG2E) - __builtin_amdgcn_exp2f(d2 * LOG2E) + lam_init;
    LAS float* btab = (LAS float*)(F.lds + BTAB_OFF);
    const float* rpb = INP(2) + (size_t)l * 3720;
    { float tv[8];
#pragma unroll
      for (int i = 0; i < 8; ++i) { const int ix = F.tid + 512 * i; tv[i] = rpb[ix < 3720 ? ix : 3719]; }
#pragma unroll
      for (int i = 0; i < 8; ++i) { const int ix = F.tid + 512 * i; if (ix < 3720) btab[ix] = tv[i] * LOG2E; } }
    __syncthreads();
    const bf16* QA = WSP(bf16, WS_QA); const bf16* QB = WSP(bf16, WS_QB); const bf16* QC = WSP(bf16, WS_QC);
    for (int rep_ = 0; rep_ < REP_DIFF; ++rep_) if (ATTMASK & 1) { const int u = F.vcu; diff_unit(F.lds, QB, WSP(bf16, WS_YB), WSP(float, WS_STASH) + (size_t)F.bx * 32768, u >> 6, (u >> 4) & 3, u & 15, lam, 1.0f - lam_init, INP(7) + l * 128); }
    LAS unsigned char* vbuf = F.lds + 49152 + wave * 8192;
    for (int rep_ = 0; rep_ < REP_NA; ++rep_) if (ATTMASK & 2) na_band(F.lds, btab, QA, WSP(bf16, WS_YA), F.vcu >> 6, (F.vcu >> 3) & 7, F.vcu & 7, wave, lane);
    bf16* OC = WSP(bf16, WS_OC); float* LSE = WSP(float, WS_LSE);
    const int ub = F.vcu >> 6, uj = (F.vcu >> 4) & 3, usp = F.vcu & 15;
#pragma unroll 1
    for (int it6 = 0; it6 < ((ATTMASK & 4) ? 6 * REP_DIL : 0); ++it6) { const int it = it6 % 6;
        const int tl = wave * 6 + it, gi = tl >> 4, w = tl & 15;
        const int dil = (gi == 0) ? 1 : (gi == 1) ? 4 : 16, L = SEQ / dil;
        const int p = (gi == 0) ? 0 : (gi == 1) ? (w >> 2) : w;
        const int l0 = (gi == 0) ? (usp * 256 + 16 * w) : (gi == 1) ? (usp * 64 + 16 * (w & 3)) : (usp * 16);
        const int hc = gi * 4 + uj;
        const size_t tq = (size_t)ub * SEQ + (size_t)(l0 + qi) * dil + p;
        DilKey kf{(size_t)ub * SEQ + p, l0, dil, L}; DilBias bf{l0, L, l0 + qi};
        f32x4 O[4]; float mx, ls;
        win_tile<10, 0>(vbuf, QC, 2304, tq, hc * 64, 768 + hc * 64, 1536 + hc * 64, kf, bf, O, mx, ls, lane);
        const float inv = 1.0f / ls;
#pragma unroll
        for (int dt = 0; dt < 4; ++dt) { v2u w2; w2.x = cvt_pk_bf16(O[dt][0] * inv, O[dt][1] * inv); w2.y = cvt_pk_bf16(O[dt][2] * inv, O[dt][3] * inv);
            *(v2u*)(OC + tq * 768 + hc * 64 + 16 * dt + 4 * g) = w2; }
        if (g == 0) LSE[tq * 12 + hc] = mx + __builtin_amdgcn_logf(ls);
    }
    VM_WAIT(); __syncthreads();
    bf16* YC = WSP(bf16, WS_YC);
    { float e0[4], e1[4], e2[4]; v4u qa[4], qb[4], qc[4];
#pragma unroll
      for (int i = 0; i < 4; ++i) { const int idx = F.tid + 512 * i; const size_t tok = (size_t)ub * SEQ + usp * 256 + (idx >> 3); const int ch = idx & 7;
          e0[i] = LSE[tok * 12 + uj]; e1[i] = LSE[tok * 12 + 4 + uj]; e2[i] = LSE[tok * 12 + 8 + uj];
          qa[i] = *(const v4u*)(OC + tok * 768 + uj * 64 + ch * 8); qb[i] = *(const v4u*)(OC + tok * 768 + (4 + uj) * 64 + ch * 8); qc[i] = *(const v4u*)(OC + tok * 768 + (8 + uj) * 64 + ch * 8); }
#pragma unroll
      for (int i = 0; i < 4; ++i) { const int idx = F.tid + 512 * i; const size_t tok = (size_t)ub * SEQ + usp * 256 + (idx >> 3); const int ch = idx & 7;
          const float em = fmaxf(e0[i], fmaxf(e1[i], e2[i]));
          float w0 = __builtin_amdgcn_exp2f(e0[i] - em), w1 = __builtin_amdgcn_exp2f(e1[i] - em), w2 = __builtin_amdgcn_exp2f(e2[i] - em); const float di = 1.0f / (w0 + w1 + w2); w0 *= di; w1 *= di; w2 *= di;
          v4u o;
#pragma unroll
          for (int kk = 0; kk < 4; ++kk) { const float lo = w0 * pg8::bf_lo(qa[i][kk]) + w1 * pg8::bf_lo(qb[i][kk]) + w2 * pg8::bf_lo(qc[i][kk]), hi = w0 * pg8::bf_hi(qa[i][kk]) + w1 * pg8::bf_hi(qb[i][kk]) + w2 * pg8::bf_hi(qc[i][kk]); o[kk] = cvt_pk_bf16(lo, hi); }
          *(v4u*)(YC + tok * 256 + uj * 64 + ch * 8) = o; } }
}

#ifndef PHMASK
#define PHMASK 0xFFFF
#endif
struct Args { const float* in[22]; float* out; unsigned char* ws; int ph_lo, ph_hi; };
__global__ void __launch_bounds__(NWAVES * 64, 2) hybrid_fwd(Args args) {
    extern __shared__ __attribute__((aligned(16))) unsigned char lds[];
    Frame F;
    F.lds = (LAS unsigned char*)lds; F.MISC = (volatile LAS unsigned*)(F.lds + MISC_OFF);
    F.tid = threadIdx.x; F.lane = F.tid & 63; F.wave = __builtin_amdgcn_readfirstlane(F.tid >> 6);
    F.G = gridDim.x; F.bx = blockIdx.x; F.vcu = (F.bx % 8) * (F.G / 8) + F.bx / 8;
    F.ka = (const CAS unsigned char*)__builtin_amdgcn_kernarg_segment_ptr();
    F.out = args.out; F.ws = args.ws; F.ctl = (unsigned*)(args.ws + WS_CTL);
#define PHASE_BEGIN() do { F.ka = (const CAS unsigned char*)opq64((unsigned long long)__builtin_amdgcn_kernarg_segment_ptr()); \
        F.tid = pg8::opq_tid(); F.lane = F.tid & 63; F.wave = __builtin_amdgcn_readfirstlane(F.tid >> 6); \
        { int bx_ = blockIdx.x; asm volatile("" : "+s"(bx_)); F.bx = bx_; F.vcu = (bx_ % 8) * (F.G / 8) + bx_ / 8; } \
        F.out = *(float* const CAS*)(F.ka + 176); F.ws = *(unsigned char* const CAS*)(F.ka + 184); F.ctl = (unsigned*)(F.ws + WS_CTL); } while (0)
    for (int u = F.tid; u < 1024 / 4; u += NWAVES * 64) ((LAS unsigned*)(F.lds + LDSCTL_OFF))[u] = 0u;
    __syncthreads();
    const int lo = args.ph_lo, hi = args.ph_hi;
    XcdBarrier bar; bar.bar = F.ctl + CW_BAR; bar.x = 0; bar.st = F.MISC + 8;
    if (hi - lo > 1) bar = xcd_barrier_post(F.ctl + CW_BAR, F.MISC + 8);
#define IN(k) (lo <= (k) && (k) < hi)
#define SEAM(k) do { if (IN(k) && IN((k) + 1)) { for (int rb_ = 0; rb_ < REP_BAR; ++rb_) xcd_barrier(bar); } } while (0)
    if (IN(0) && (PHMASK & 1)) { PHASE_BEGIN(); rope_tables(F); router_tables(F); conv_layer(F, 0); norm_rows(F, INP(0), F.out, WSP(float, WS_RS1), nullptr); }
    SEAM(0);
#pragma unroll 1
    for (int l = 0; l < DEPTH; ++l) {
        const int pb = 1 + 8 * l;
        if (IN(pb) && (PHMASK & 2)) {
            PHASE_BEGIN(); bf16* ABF = WSP(bf16, WS_ABF);
            pg8::Gemm g{opq(ABF), opq(WSW(WS_WIN, l)), NTOK, INW, DM}; pg8::StaticOrder S; S.init(NTOK, INW, F.G, F.bx);
            pg8::EpiProj E{WSP(bf16, WS_QA), WSP(bf16, WS_QB), WSP(bf16, WS_QC), WSP(bf16, WS_GATE), WSP(float, WS_RS1), WSP(float, WS_ROPEC), WSP(float, WS_ROPES)};
            for (int rep_ = 0; rep_ < REP_G1; ++rep_) pg8::gemm_phase<pg8::EpiProj, pg8::StaticOrder, true, true>(F.lds, g, S, E);
            if (l + 1 < DEPTH && (FILL_MASK & 1)) { phase_done(F, pb); conv_fill(F, l + 1, F.ctl + CW_DONE + 64 * pb); }
        }
        SEAM(pb);
        if (IN(pb + 1) && (PHMASK & 4)) { PHASE_BEGIN(); att_phase(F, l); }
        SEAM(pb + 1);
        if (IN(pb + 2) && (PHMASK & 8)) {
            PHASE_BEGIN();
            for (int rep_ = 0; rep_ < REP_G2; ++rep_) {
            { pg8::Gemm g{opq(WSP(bf16, WS_YA)), opq(WSW(WS_WPA, l)), NTOK, DM, 512}; pg8::StaticOrder S; S.init(NTOK, DM, F.G, F.bx);
              pg8::EpiGate<true> E{WSP(bf16, WS_MERGED), WSP(bf16, WS_GATE), 0}; pg8::gemm_phase<pg8::EpiGate<true>, pg8::StaticOrder, true, true>(F.lds, g, S, E); }
            VM_WAIT(); __syncthreads();
            { pg8::Gemm g{opq(WSP(bf16, WS_YB)), opq(WSW(WS_WPB, l)), NTOK, DM, 512}; pg8::StaticOrder S; S.init(NTOK, DM, F.G, F.bx);
              pg8::EpiGate<false> E{WSP(bf16, WS_MERGED), WSP(bf16, WS_GATE), 1024}; pg8::gemm_phase<pg8::EpiGate<false>, pg8::StaticOrder, true, true>(F.lds, g, S, E); }
            VM_WAIT(); __syncthreads();
            { pg8::Gemm g{opq(WSP(bf16, WS_YC)), opq(WSW(WS_WPC, l)), NTOK, DM, 256}; pg8::StaticOrder S; S.init(NTOK, DM, F.G, F.bx);
              pg8::EpiGate<false> E{WSP(bf16, WS_MERGED), WSP(bf16, WS_GATE), 2048}; pg8::gemm_phase<pg8::EpiGate<false>, pg8::StaticOrder, true, true>(F.lds, g, S, E); }
            VM_WAIT(); __syncthreads(); }
        }
        SEAM(pb + 2);
        if (IN(pb + 3) && (PHMASK & 16)) {
            PHASE_BEGIN();
            pg8::Gemm g{opq(WSP(bf16, WS_MERGED)), opq(WSW(WS_WO, l)), NTOK, DM, DM}; pg8::StaticOrder S; S.init(NTOK, DM, F.G, F.bx);
            if (REP_G3 > 1) { pg8::EpiResid E0{F.out, WSP(float, WS_H1), DM}; pg8::gemm_phase<pg8::EpiResid, pg8::StaticOrder, true, true>(F.lds, g, S, E0); VM_WAIT(); __syncthreads(); }
            pg8::EpiResid E{F.out, F.out, DM}; pg8::gemm_phase<pg8::EpiResid, pg8::StaticOrder, true, true>(F.lds, g, S, E);
        }
        SEAM(pb + 3);
        if (IN(pb + 4) && (PHMASK & 32)) { PHASE_BEGIN(); if (REP_N2 > 1) norm_route(F, l, false); norm_route(F, l, true); }
        SEAM(pb + 4);
        if (IN(pb + 5) && (PHMASK & 64)) {
            PHASE_BEGIN();
            pg8::MoeOrder S; { LAS int* tab = (LAS int*)(F.lds + LDSCTL_OFF); const unsigned* gc = F.ctl + CW_CNT + l * 1024;
                if (F.tid < 64) { const int c = (F.lane < 16) ? (int)__hip_atomic_load(gc + 64 * F.lane, __ATOMIC_RELAXED, __HIP_MEMORY_SCOPE_AGENT) : 0;
                    int incl = (c + 255) >> 8;
#pragma unroll
                    for (int o = 1; o < 16; o <<= 1) { const int y = __shfl_up(incl, o); if (F.lane >= o) incl += y; }
                    if (F.lane < 16) { tab[17 + F.lane] = c; tab[F.lane] = incl - ((c + 255) >> 8); } if (F.lane == 15) tab[16] = incl; }
                __syncthreads();
                S.tab = tab; S.list = opq(WSP(unsigned, WS_LIST)); S.G = F.G; S.c = F.bx; }
            pg8::Gemm g{opq(WSP(bf16, WS_ABF)), opq(WSW(WS_W13, l)), NTOK, 16384, DM};
            pg8::EpiSwiglu E{WSP(bf16, WS_H1), WSP(float, WS_RS2), S.list}; for (int rep_ = 0; rep_ < REP_M1; ++rep_) pg8::gemm_phase_g<pg8::EpiSwiglu, pg8::MoeOrder>(F.lds, g, S, E);
            if (l + 1 < DEPTH && (FILL_MASK & 2)) { phase_done(F, pb + 5); conv_fill(F, l + 1, F.ctl + CW_DONE + 64 * (pb + 5)); }
        }
        SEAM(pb + 5);
        if (IN(pb + 6) && (PHMASK & 128)) {
            PHASE_BEGIN();
            pg8::MoeOrder S; { LAS int* tab = (LAS int*)(F.lds + LDSCTL_OFF); const unsigned* gc = F.ctl + CW_CNT + l * 1024;
                if (F.tid < 64) { const int c = (F.lane < 16) ? (int)__hip_atomic_load(gc + 64 * F.lane, __ATOMIC_RELAXED, __HIP_MEMORY_SCOPE_AGENT) : 0;
                    int incl = (c + 255) >> 8;
#pragma unroll
                    for (int o = 1; o < 16; o <<= 1) { const int y = __shfl_up(incl, o); if (F.lane >= o) incl += y; }
                    if (F.lane < 16) { tab[17 + F.lane] = c; tab[F.lane] = incl - ((c + 255) >> 8); } if (F.lane == 15) tab[16] = incl; }
                __syncthreads();
                S.tab = tab; S.list = opq(WSP(unsigned, WS_LIST)); S.G = F.G; S.c = F.bx; }
            pg8::Gemm g{opq(WSP(bf16, WS_H1)), opq(WSW(WS_W2, l)), 36864, 16384, 512};
            pg8::EpiMoeOut E{WSP(bf16, WS_CB), WSP(float, WS_COMB), S.list}; for (int rep_ = 0; rep_ < REP_M2; ++rep_) pg8::gemm_phase<pg8::EpiMoeOut, pg8::MoeOrder, true, true>(F.lds, g, S, E);
            if (l + 1 < DEPTH && (FILL_MASK & 4)) { phase_done(F, pb + 6); conv_fill(F, l + 1, F.ctl + CW_DONE + 64 * (pb + 6)); }
        }
        SEAM(pb + 6);
        if (IN(pb + 7) && (PHMASK & 256)) { PHASE_BEGIN(); if (l + 1 < DEPTH) { conv_rest(F, l + 1); if (REP_NR > 1) norm_rows(F, F.out, WSP(float, WS_QA), WSP(float, WS_RS1), WSP(bf16, WS_CB)); norm_rows(F, F.out, F.out, WSP(float, WS_RS1), WSP(bf16, WS_CB)); } else final_norm(F); }
        if (l + 1 < DEPTH) SEAM(pb + 7);
    }
#undef IN
#undef SEAM
}

extern "C" void kernel_launch(void* const* d_in, const int* in_sizes, int n_in, void* d_out, int out_size, void* d_ws, size_t ws_size, hipStream_t stream) {
    static int grid = 0;
    if (grid == 0) {
        if (n_in != 22 || out_size != NTOK * DM || ws_size < WS_END) { fprintf(stderr, "kernel_launch: unexpected problem (n_in %d, out %d, ws %zu); nothing launched\n", n_in, out_size, ws_size); grid = -1; return; }
        int dev = 0, cus = 0;
        if (hipGetDevice(&dev) != hipSuccess || hipDeviceGetAttribute(&cus, hipDeviceAttributeMultiprocessorCount, dev) != hipSuccess) { grid = -1; return; }
        if (hipFuncSetAttribute((const void*)hybrid_fwd, hipFuncAttributeMaxDynamicSharedMemorySize, LDS_BYTES) != hipSuccess) { fprintf(stderr, "kernel_launch: hipFuncSetAttribute failed\n"); grid = -1; return; }
        int per_cu = 0; (void)hipOccupancyMaxActiveBlocksPerMultiprocessor(&per_cu, (const void*)hybrid_fwd, NWAVES * 64, LDS_BYTES); (void)hipGetLastError();
        grid = (cus == 256) ? 256 : -1;
        if (grid < 0) { fprintf(stderr, "kernel_launch: %d CUs, built for 256; nothing launched\n", cus); return; }
    }
    if (grid < 0) return;
    (void)hipMemsetAsync((char*)d_ws + WS_CTL, 0, CTL_ZERO_BYTES, stream);
    Args a{};
    for (int i = 0; i < 22; ++i) a.in[i] = (const float*)d_in[i];
    a.out = (float*)d_out; a.ws = (unsigned char*)d_ws;
#if MK_ONE_LAUNCH
    a.ph_lo = 0; a.ph_hi = N_PHASES;
    hipLaunchKernelGGL(hybrid_fwd, dim3(grid), dim3(NWAVES * 64), LDS_BYTES, stream, a);
#else
    for (int p = 0; p < N_PHASES; ++p) { a.ph_lo = p; a.ph_hi = p + 1; hipLaunchKernelGGL(hybrid_fwd, dim3(grid), dim3(NWAVES * 64), LDS_BYTES, stream, a); }
#endif
}
```
